# Optimizing an MI355X kernel written in HIP

```python
import math
import jax, jax.numpy as jnp
from jax import lax
import numpy as np

D_MODEL = 1024
BATCH = 4
SEQ = 4096
DEPTH = 4
DEC_BATCH = 128
DEC_SEQ = 1
PAST_LEN = 8192
PAGE_SIZE = 128

N_MIXERS = 2
N_SWA_LAYERS = (DEPTH + 1) // 2
N_SSM_LAYERS = DEPTH // 2
HEAD_DIM = 64
N_HEADS = D_MODEL // HEAD_DIM
N_KV_HEADS = 4
GQA_GROUP = N_HEADS // N_KV_HEADS
WINDOW = 128
ATTN_BLOCK = WINDOW
CACHE_WIN = min(WINDOW, PAST_LEN)
PROMPT_WIN = min(WINDOW, SEQ)
SSM_GROUP = 16
N_SSM_GROUPS = D_MODEL // SSM_GROUP
SSM_STATE = 64
D_FF = 2816
CONV_W = 3
RMS_EPS = 1e-6
DT_MIN = 1e-3
DT_MAX = 1e-1

kernel_name = "swa_sink_s5_convffn_hybrid_step"

F32 = jnp.float32


def rmsnorm(x, g):
    xf = x.astype(F32)
    y = xf * lax.rsqrt(jnp.mean(xf * xf, axis=-1, keepdims=True) + RMS_EPS)
    return (y * g.astype(F32)).astype(x.dtype)


def qkv_project(h, w_qkv, q_gain, k_gain):
    n, l, _ = h.shape
    qkv = h @ w_qkv
    q, k, v = jnp.split(qkv, [N_HEADS * HEAD_DIM, (N_HEADS + N_KV_HEADS) * HEAD_DIM], axis=-1)
    q = rmsnorm(q.reshape(n, l, N_KV_HEADS, GQA_GROUP, HEAD_DIM), q_gain)
    k = rmsnorm(k.reshape(n, l, N_KV_HEADS, HEAD_DIM), k_gain)
    v = v.reshape(n, l, N_KV_HEADS, HEAD_DIM)
    return q, k, v


def sink_attend(scores, valid, sink, v, eq):
    scores = jnp.where(valid, scores, -jnp.inf)
    sink_col = jnp.broadcast_to(sink.astype(F32).reshape(N_KV_HEADS, GQA_GROUP, 1, 1),
                                scores.shape[:-1] + (1,))
    probs = jax.nn.softmax(jnp.concatenate([scores, sink_col], axis=-1), axis=-1)[..., :-1]
    return jnp.einsum(eq, probs.astype(v.dtype), v)


def swa_prompt(h, w_qkv, w_o, q_gain, k_gain, sink):
    n, l, _ = h.shape
    nb = l // ATTN_BLOCK
    q, k, v = qkv_project(h, w_qkv, q_gain, k_gain)
    qb = q.reshape(n, nb, ATTN_BLOCK, N_KV_HEADS, GQA_GROUP, HEAD_DIM)
    kb = k.reshape(n, nb, ATTN_BLOCK, N_KV_HEADS, HEAD_DIM)
    vb = v.reshape(n, nb, ATTN_BLOCK, N_KV_HEADS, HEAD_DIM)

    def band(t):
        prev = jnp.concatenate([jnp.zeros_like(t[:, :1]), t[:, :-1]], axis=1)
        return jnp.concatenate([prev, t], axis=2)

    kk, vv = band(kb), band(vb)
    scores = jnp.einsum('nbqkgd,nbskd->nbkgqs', qb.astype(F32), kk.astype(F32)) * HEAD_DIM ** -0.5
    blk = jnp.arange(nb)[:, None, None]
    qpos = blk * ATTN_BLOCK + jnp.arange(ATTN_BLOCK)[None, :, None]
    kpos = (blk - 1) * ATTN_BLOCK + jnp.arange(2 * ATTN_BLOCK)[None, None, :]
    diff = qpos - kpos
    valid = (diff >= 0) & (diff < WINDOW) & (kpos >= 0)
    o = sink_attend(scores, valid[:, None, None], sink, vv, 'nbkgqs,nbskd->nbqkgd')
    o = o.reshape(n, l, N_HEADS * HEAD_DIM) @ w_o
    return o, k[:, -PROMPT_WIN:], v[:, -PROMPT_WIN:]


def swa_sample(h, cache_k, cache_v, w_qkv, w_o, q_gain, k_gain, sink):
    n, s, _ = h.shape
    q, k, v = qkv_project(h, w_qkv, q_gain, k_gain)
    kk = jnp.concatenate([cache_k.astype(k.dtype), k], axis=1)
    vv = jnp.concatenate([cache_v.astype(v.dtype), v], axis=1)
    scores = jnp.einsum('nqkgd,nskd->nkgqs', q.astype(F32), kk.astype(F32)) * HEAD_DIM ** -0.5
    qpos = PAST_LEN + jnp.arange(s)[:, None]
    kpos = jnp.concatenate([PAST_LEN - CACHE_WIN + jnp.arange(CACHE_WIN),
                            PAST_LEN + jnp.arange(s)])[None, :]
    diff = qpos - kpos
    valid = (diff >= 0) & (diff < WINDOW)
    o = sink_attend(scores, valid, sink, vv, 'nkgqs,nskd->nqkgd')
    o = o.reshape(n, s, N_HEADS * HEAD_DIM) @ w_o
    return o, kk[:, -CACHE_WIN:], vv[:, -CACHE_WIN:]


def s5_discretize(a_re, a_im, log_dt, b_re, b_im):
    a_re, a_im = a_re.astype(F32), a_im.astype(F32)
    dt = jnp.exp(log_dt.astype(F32))[:, None]
    mag = jnp.exp(a_re * dt)
    ab_re, ab_im = mag * jnp.cos(a_im * dt), mag * jnp.sin(a_im * dt)
    den = a_re * a_re + a_im * a_im
    c_re = ((ab_re - 1.0) * a_re + ab_im * a_im) / den
    c_im = (ab_im * a_re - (ab_re - 1.0) * a_im) / den
    b_re, b_im = b_re.astype(F32), b_im.astype(F32)
    bb_re = c_re[..., None] * b_re - c_im[..., None] * b_im
    bb_im = c_re[..., None] * b_im + c_im[..., None] * b_re
    return ab_re, ab_im, bb_re, bb_im


def complex_affine_combine(e1, e2):
    a1r, a1i, b1r, b1i = e1
    a2r, a2i, b2r, b2i = e2
    return (a2r * a1r - a2i * a1i, a2r * a1i + a2i * a1r,
            a2r * b1r - a2i * b1i + b2r, a2r * b1i + a2i * b1r + b2i)


def s5_mixer(h, st_re, st_im, a_re, a_im, log_dt, b_re, b_im, c_re, c_im, d_skip, w_glu):
    n, l, _ = h.shape
    ab_re, ab_im, bb_re, bb_im = s5_discretize(a_re, a_im, log_dt, b_re, b_im)
    u = h.astype(F32).reshape(n, l, N_SSM_GROUPS, SSM_GROUP)
    bu_re = jnp.einsum('nlgc,gpc->nlgp', u, bb_re)
    bu_im = jnp.einsum('nlgc,gpc->nlgp', u, bb_im)
    h0_re, h0_im = st_re.astype(F32), st_im.astype(F32)
    bu_re = bu_re.at[:, 0].add(ab_re * h0_re - ab_im * h0_im)
    bu_im = bu_im.at[:, 0].add(ab_re * h0_im + ab_im * h0_re)
    a_r = jnp.broadcast_to(ab_re, bu_re.shape)
    a_i = jnp.broadcast_to(ab_im, bu_im.shape)
    _, _, xr, xi = lax.associative_scan(complex_affine_combine, (a_r, a_i, bu_re, bu_im), axis=1)
    y = (jnp.einsum('nlgp,gcp->nlgc', xr, c_re.astype(F32))
         - jnp.einsum('nlgp,gcp->nlgc', xi, c_im.astype(F32)))
    y = y.reshape(n, l, D_MODEL) + d_skip.astype(F32) * h.astype(F32)
    z = jax.nn.gelu(y).astype(h.dtype)
    zz = z @ w_glu
    out = zz[..., :D_MODEL] * jax.nn.sigmoid(zz[..., D_MODEL:])
    return out, xr[:, -1].astype(st_re.dtype), xi[:, -1].astype(st_im.dtype)


def conv_ffn(h, buf, w_up, conv_w, conv_b, w_down):
    up = h @ w_up
    l = up.shape[1]
    padded = jnp.concatenate([buf.astype(up.dtype), up], axis=1)
    c = conv_b
    for j in range(CONV_W):
        c = c + conv_w[j] * padded[:, j:j + l]
    g, v = jnp.split(c, 2, axis=-1)
    out = (jax.nn.silu(g) * v) @ w_down
    return out, padded[:, -(CONV_W - 1):]


def trunk(x, cache_k, cache_v, st_re, st_im, st_conv, norm_mix, norm_ffn, w_qkv, w_o, q_norm,
          k_norm, sinks, ssm_a_re, ssm_a_im, ssm_log_dt, ssm_b_re, ssm_b_im, ssm_c_re, ssm_c_im,
          ssm_d, w_glu, w_up, conv_w, conv_b, w_down):
    ks, vs, srs, sis, cbs = [], [], [], [], []
    for i in range(DEPTH):
        j = i // N_MIXERS
        h = rmsnorm(x, norm_mix[i])
        if i % N_MIXERS == 0:
            if cache_k is None:
                o, nk, nv = swa_prompt(h, w_qkv[j], w_o[j], q_norm[j], k_norm[j], sinks[j])
            else:
                o, nk, nv = swa_sample(h, cache_k[j], cache_v[j], w_qkv[j], w_o[j], q_norm[j],
                                       k_norm[j], sinks[j])
            ks.append(nk)
            vs.append(nv)
        else:
            o, sr, si = s5_mixer(h, st_re[j], st_im[j], ssm_a_re[j], ssm_a_im[j], ssm_log_dt[j],
                                 ssm_b_re[j], ssm_b_im[j], ssm_c_re[j], ssm_c_im[j], ssm_d[j], w_glu[j])
            srs.append(sr)
            sis.append(si)
        x = x + o
        h = rmsnorm(x, norm_ffn[i])
        o, cb = conv_ffn(h, st_conv[i], w_up[i], conv_w[i], conv_b[i], w_down[i])
        cbs.append(cb)
        x = x + o
    return x, jnp.stack(ks), jnp.stack(vs), jnp.stack(srs), jnp.stack(sis), jnp.stack(cbs)


def setup_inputs(seed: int = 0) -> dict:
    key = jax.random.key(seed)
    k = jax.random.split(key, 32)
    nrm = jax.random.normal
    F2 = 2 * D_FF
    n_idx = jnp.arange(SSM_STATE, dtype=F32)
    return {
        "x_prompt": nrm(k[0], (BATCH, SEQ, D_MODEL), F32),
        "x_sample": nrm(k[1], (DEC_BATCH, DEC_SEQ, D_MODEL), F32),
        "cache_k": nrm(k[2], (N_SWA_LAYERS, DEC_BATCH, CACHE_WIN, N_KV_HEADS, HEAD_DIM), F32),
        "cache_v": nrm(k[3], (N_SWA_LAYERS, DEC_BATCH, CACHE_WIN, N_KV_HEADS, HEAD_DIM), F32),
        "state_ssm_re": 0.5 * nrm(k[4], (N_SSM_LAYERS, DEC_BATCH, N_SSM_GROUPS, SSM_STATE), F32),
        "state_ssm_im": 0.5 * nrm(k[5], (N_SSM_LAYERS, DEC_BATCH, N_SSM_GROUPS, SSM_STATE), F32),
        "state_conv": nrm(k[6], (DEPTH, DEC_BATCH, CONV_W - 1, F2), F32),
        "norm_mix": 1.0 + 0.05 * nrm(k[7], (DEPTH, D_MODEL), F32),
        "norm_ffn": 1.0 + 0.05 * nrm(k[8], (DEPTH, D_MODEL), F32),
        "w_qkv": nrm(k[9], (N_SWA_LAYERS, D_MODEL, (N_HEADS + 2 * N_KV_HEADS) * HEAD_DIM), F32) * D_MODEL ** -0.5,
        "w_o": nrm(k[10], (N_SWA_LAYERS, N_HEADS * HEAD_DIM, D_MODEL), F32) * (N_HEADS * HEAD_DIM) ** -0.5,
        "q_norm": 1.0 + 0.05 * nrm(k[11], (N_SWA_LAYERS, HEAD_DIM), F32),
        "k_norm": 1.0 + 0.05 * nrm(k[12], (N_SWA_LAYERS, HEAD_DIM), F32),
        "sinks": 0.5 * nrm(k[13], (N_SWA_LAYERS, N_HEADS), F32),
        "ssm_a_re": -0.5 + 0.01 * nrm(k[14], (N_SSM_LAYERS, N_SSM_GROUPS, SSM_STATE), F32),
        "ssm_a_im": math.pi * n_idx + 0.01 * nrm(k[15], (N_SSM_LAYERS, N_SSM_GROUPS, SSM_STATE), F32),
        "ssm_log_dt": jax.random.uniform(k[16], (N_SSM_LAYERS, N_SSM_GROUPS), F32,
                                         math.log(DT_MIN), math.log(DT_MAX)),
        "ssm_b_re": nrm(k[17], (N_SSM_LAYERS, N_SSM_GROUPS, SSM_STATE, SSM_GROUP), F32) * (2 * SSM_GROUP) ** -0.5,
        "ssm_b_im": nrm(k[18], (N_SSM_LAYERS, N_SSM_GROUPS, SSM_STATE, SSM_GROUP), F32) * (2 * SSM_GROUP) ** -0.5,
        "ssm_c_re": nrm(k[19], (N_SSM_LAYERS, N_SSM_GROUPS, SSM_GROUP, SSM_STATE), F32) * SSM_STATE ** -0.5,
        "ssm_c_im": nrm(k[20], (N_SSM_LAYERS, N_SSM_GROUPS, SSM_GROUP, SSM_STATE), F32) * SSM_STATE ** -0.5,
        "ssm_d": nrm(k[21], (N_SSM_LAYERS, D_MODEL), F32),
        "w_glu": nrm(k[22], (N_SSM_LAYERS, D_MODEL, 2 * D_MODEL), F32) * D_MODEL ** -0.5,
        "w_up": nrm(k[23], (DEPTH, D_MODEL, F2), F32) * D_MODEL ** -0.5,
        "conv_w": nrm(k[24], (DEPTH, CONV_W, F2), F32) * CONV_W ** -0.5,
        "conv_b": 0.01 * nrm(k[25], (DEPTH, F2), F32),
        "w_down": nrm(k[26], (DEPTH, D_FF, D_MODEL), F32) * D_FF ** -0.5,
    }


def reference(x_prompt, x_sample, cache_k, cache_v, state_ssm_re, state_ssm_im, state_conv,
              norm_mix, norm_ffn, w_qkv, w_o, q_norm, k_norm, sinks, ssm_a_re, ssm_a_im,
              ssm_log_dt, ssm_b_re, ssm_b_im, ssm_c_re, ssm_c_im, ssm_d, w_glu, w_up, conv_w,
              conv_b, w_down):
    dt = x_prompt.dtype
    zero_re = jnp.zeros((N_SSM_LAYERS, BATCH, N_SSM_GROUPS, SSM_STATE), dt)
    zero_im = jnp.zeros((N_SSM_LAYERS, BATCH, N_SSM_GROUPS, SSM_STATE), dt)
    zero_conv = jnp.zeros((DEPTH, BATCH, CONV_W - 1, 2 * D_FF), dt)
    y_prompt, k_prompt, v_prompt, ssm_re_prompt, ssm_im_prompt, conv_prompt = trunk(
        x_prompt, None, None, zero_re, zero_im, zero_conv, norm_mix, norm_ffn, w_qkv, w_o,
        q_norm, k_norm, sinks, ssm_a_re, ssm_a_im, ssm_log_dt, ssm_b_re, ssm_b_im, ssm_c_re,
        ssm_c_im, ssm_d, w_glu, w_up, conv_w, conv_b, w_down)
    y_sample, k_sample, v_sample, ssm_re_sample, ssm_im_sample, conv_sample = trunk(
        x_sample, cache_k, cache_v, state_ssm_re, state_ssm_im, state_conv, norm_mix, norm_ffn,
        w_qkv, w_o, q_norm, k_norm, sinks, ssm_a_re, ssm_a_im, ssm_log_dt, ssm_b_re, ssm_b_im,
        ssm_c_re, ssm_c_im, ssm_d, w_glu, w_up, conv_w, conv_b, w_down)
    return (y_prompt, y_sample, k_prompt, v_prompt, k_sample, v_sample, ssm_re_prompt,
            ssm_im_prompt, ssm_re_sample, ssm_im_sample, conv_prompt, conv_sample)
```

```cpp
#include <hip/hip_runtime.h>
#include <cstdio>
#include <cstdint>
#include <cmath>

constexpr int D = 1024, NB = 4, SEQ = 4096, DEPTH = 4, DB = 128;
constexpr int MP = NB * SEQ;
constexpr int MT = MP + DB;
constexpr int NH = 16, NKV = 4, HD = 64, WIN = 128;
constexpr int NQKV = (NH + 2 * NKV) * HD;
constexpr int NG = 64, SG = 16, NS = 64;
constexpr int FF = 2816, F2 = 2 * FF;
constexpr float EPS = 1e-6f;

constexpr size_t O_Y = 0;
constexpr size_t O_YS = O_Y + (size_t)MP * D;
constexpr size_t O_KP = O_YS + (size_t)DB * D;
constexpr size_t O_VP = O_KP + (size_t)2 * NB * WIN * NKV * HD;
constexpr size_t O_KS = O_VP + (size_t)2 * NB * WIN * NKV * HD;
constexpr size_t O_VS = O_KS + (size_t)2 * DB * WIN * NKV * HD;
constexpr size_t O_SRP = O_VS + (size_t)2 * DB * WIN * NKV * HD;
constexpr size_t O_SIP = O_SRP + (size_t)2 * NB * NG * NS;
constexpr size_t O_SRS = O_SIP + (size_t)2 * NB * NG * NS;
constexpr size_t O_SIS = O_SRS + (size_t)2 * DB * NG * NS;
constexpr size_t O_CP = O_SIS + (size_t)2 * DB * NG * NS;
constexpr size_t O_CS = O_CP + (size_t)DEPTH * NB * 2 * F2;
constexpr size_t O_END = O_CS + (size_t)DEPTH * DB * 2 * F2;

#define GAS __attribute__((address_space(1)))
#define LAS __attribute__((address_space(3)))
typedef unsigned short bf16;
typedef unsigned v4u __attribute__((ext_vector_type(4)));
typedef unsigned v2u __attribute__((ext_vector_type(2)));
typedef float f32x4 __attribute__((ext_vector_type(4)));
typedef float f32x2 __attribute__((ext_vector_type(2)));
typedef short bf16x8 __attribute__((ext_vector_type(8)));
typedef GAS unsigned gu32;
#define RLX_AGENT __ATOMIC_RELAXED, __HIP_MEMORY_SCOPE_AGENT
#define LDS_WAIT() asm volatile("s_waitcnt lgkmcnt(0)" ::: "memory")
#define VM_WAIT() asm volatile("s_waitcnt vmcnt(0)" ::: "memory")
__device__ __forceinline__ unsigned pk2(float lo, float hi) { unsigned r; asm("v_cvt_pk_bf16_f32 %0, %1, %2" : "=v"(r) : "v"(lo), "v"(hi)); return r; }
__device__ __forceinline__ unsigned f2bf(float f) { return pk2(f, 0.f) & 0xffffu; }
__device__ __forceinline__ unsigned pk2q(float lo, float hi) { return __builtin_amdgcn_perm(__builtin_bit_cast(unsigned, hi) + 0x8000u, __builtin_bit_cast(unsigned, lo) + 0x8000u, 0x07060302u); }
__device__ __forceinline__ float bf2f(unsigned short b) { return __builtin_bit_cast(float, (unsigned)b << 16); }
__device__ __forceinline__ float dpp_shr1(float v) { return __builtin_bit_cast(float, __builtin_amdgcn_update_dpp(0, __builtin_bit_cast(int, v), 0x111, 0xf, 0xf, true)); }

__device__ __forceinline__ int opaque_tid() { int t = threadIdx.x; asm volatile("" : "+v"(t)); return t; }

__device__ __forceinline__ float wave_sum(float v) {
#pragma unroll
    for (int o = 1; o < 64; o <<= 1) v += __shfl_xor(v, o);
    return v;
}

constexpr float LOG2E = 1.4426950408889634f;
constexpr float QSCALE = 0.125f * LOG2E;

constexpr size_t MiB = 1u << 20;
constexpr size_t WS_CTL = 0, CTL_ZERO_BYTES = 1 * MiB;
constexpr size_t WS_WQKV = 1 * MiB;
constexpr size_t WS_WO = 7 * MiB;
constexpr size_t WS_WGLU = 11 * MiB;
constexpr size_t WS_WUP = 19 * MiB;
constexpr size_t WS_WDN = 63 * MiB;
constexpr size_t WS_XB = 85 * MiB;
constexpr size_t WS_SS = 118 * MiB;
constexpr size_t WS_Q = 121 * MiB;
constexpr size_t WS_K = 154 * MiB;
constexpr size_t WS_V = 163 * MiB;
constexpr size_t WS_O = 172 * MiB;
constexpr size_t WS_ACT = 205 * MiB;
constexpr size_t WS_HALO = 294 * MiB;
constexpr size_t WS_SSM = 316 * MiB;
constexpr size_t WS_END = 352 * MiB;

constexpr int CW_BAR = 4096;
namespace pg8 {
#define PG8_LAS __attribute__((address_space(3)))
typedef unsigned short bf16_t;
typedef short bf16x8 __attribute__((ext_vector_type(8)));
typedef float f32x4 __attribute__((ext_vector_type(4)));
typedef unsigned u32x4 __attribute__((ext_vector_type(4)));
constexpr int BM = 256, BK = 64, HALF = 128, HTB = HALF * BK * 2  , STAGE_BYTES = 8 * HTB, NXCD = 8, WGM = 8;

__host__ __device__ __forceinline__ int lds_byte(int r, int c) { const int st = (r >> 4) * 2 + (c >> 5), rr = r & 15, cc = c & 31, ob = rr * 64 + cc * 2; return st * 1024 + (ob ^ (((ob >> 9) & 1) << 5)); }
__host__ __device__ __forceinline__ void stage_rc(int b, int& R, int& C) { const int st = b / 1024, sb = b % 1024, swz = sb ^ (((sb >> 9) & 1) << 5); R = (st >> 1) * 16 + swz / 64; C = (st & 1) * 32 + (swz % 64) / 2; }
__host__ __device__ __forceinline__ int perm32(int rho) { const int n = rho >> 4, i = rho & 15; return 8 * (i >> 2) + 4 * n + (i & 3); }

struct Unit { int pm, pn; };
struct Gemm { const bf16_t* A; const bf16_t* Bt; int M, N, K; };

struct StaticOrder {
    int nM, nN, nwg, G, c;
    __host__ __device__ void init(int M, int N, int G_, int c_) { nM = M / BM; nN = N / BM; nwg = nM * nN; G = G_; c = c_; }
    __host__ __device__ bool next(int i, Unit& u) const {
        const long L = (long)i * G + c; if (L >= nwg) return false;
        int wgid = (int)L; { const int q = nwg / NXCD, r = nwg % NXCD, xcd = wgid % NXCD, off = wgid / NXCD; wgid = (xcd < r ? xcd * (q + 1) : r * (q + 1) + (xcd - r) * q) + off; }
        const int nig = WGM * nN, gid = wgid / nig, fm = gid * WGM, gsz = (nM - fm) < WGM ? (nM - fm) : WGM;
        u.pm = fm + ((wgid % nig) % gsz); u.pn = (wgid % nig) / gsz; return true;
    }
    __device__ __forceinline__ void a_ready(const Unit&) const {}
    __device__ __forceinline__ void done(const Unit&) const {}
};

__device__ __forceinline__ unsigned cvt_pk_bf16(float lo, float hi) { unsigned r; asm volatile("v_cvt_pk_bf16_f32 %0, %1, %2" : "=v"(r) : "v"(lo), "v"(hi)); return r; }
typedef unsigned u32x2 __attribute__((ext_vector_type(2)));
__device__ __forceinline__ void st_b32(void* p, float v) { asm volatile("global_store_dword %0, %1, off" :: "v"(p), "v"(v) : "memory"); }
__device__ __forceinline__ void st_b64(void* p, u32x2 v) { asm volatile("global_store_dwordx2 %0, %1, off" :: "v"(p), "v"(v) : "memory"); }
__device__ __forceinline__ void st_b128(void* p, u32x4 v) { asm volatile("global_store_dwordx4 %0, %1, off\n\ts_nop 1" :: "v"(p), "v"(v) : "memory"); }
__device__ __forceinline__ void st_f128(void* p, f32x4 v) { asm volatile("global_store_dwordx4 %0, %1, off\n\ts_nop 1" :: "v"(p), "v"(v) : "memory"); }

template <bool APERM>
__device__ __forceinline__ void row_scales(const float* __restrict__ ss, int np4  , int rowbase  , int lane, int fr, float (&rs)[2][4]) {
    const int mm = lane >> 4, ff = lane & 15, rloc = APERM ? (4 * ff + mm) : (16 * mm + ff);
    float v[2];
#pragma unroll
    for (int ai = 0; ai < 2; ++ai) {
        const f32x4* p = (const f32x4*)(ss + (size_t)(rowbase + 128 * ai + rloc) * 32);
        float s = 0.f;
        for (int i = 0; i < np4; ++i) { const f32x4 t = p[i]; s += (t[0] + t[1]) + (t[2] + t[3]); }
        v[ai] = __builtin_amdgcn_rsqf(s * (1.0f / 1024.0f) + 1e-6f);
    }
#pragma unroll
    for (int ai = 0; ai < 2; ++ai)
#pragma unroll
        for (int m = 0; m < 4; ++m) rs[ai][m] = __shfl(v[ai], 16 * m + fr);
}

struct EpiQKV {
    bf16_t* Q; bf16_t* Kb; bf16_t* Vb; PG8_LAS const float* rsl; PG8_LAS const float* qg; PG8_LAS const float* kg; float* kout; float* vout;
    __device__ __forceinline__ void operator()(const f32x4 (&acc)[2][2][4][2], const Unit& u, int ui, int wr, int wc, int fr, int fq) const {
        const int rowbase = u.pm * BM + wr * 64;
        float rs[2][4];
#pragma unroll
        for (int ai = 0; ai < 2; ++ai)
#pragma unroll
            for (int m = 0; m < 4; ++m) rs[ai][m] = rsl[ui * 256 + 128 * ai + 64 * wr + 16 * m + fr];
        const int kind = u.pn < 4 ? 0 : (u.pn == 4 ? 1 : 2);
        f32x4 gn[2][2];
#pragma unroll
        for (int bj = 0; bj < 2; ++bj)
#pragma unroll
            for (int n = 0; n < 2; ++n) gn[bj][n] = kind == 2 ? (f32x4){1.f, 1.f, 1.f, 1.f} : *(const PG8_LAS f32x4*)((kind == 0 ? qg : kg) + 32 * bj + 8 * fq + 4 * n);
        bf16_t* dst = kind == 0 ? Q + (size_t)(4 * u.pn + wc) * 64 : (kind == 1 ? Kb : Vb) + (size_t)wc * 64;
        const int pitch = kind == 0 ? 1024 : 256;
        const bool tail = (kind != 0) && ((u.pm & 15) == 15);
        float* fo = kind == 1 ? kout : vout;
#pragma unroll
        for (int ai = 0; ai < 2; ++ai)
#pragma unroll
            for (int m = 0; m < 4; ++m) {
                const int row = rowbase + 128 * ai + 16 * m + fr; const float r = rs[ai][m];
                f32x4 v[2][2]; float s = 0.f;
#pragma unroll
                for (int bj = 0; bj < 2; ++bj)
#pragma unroll
                    for (int n = 0; n < 2; ++n) { v[bj][n] = acc[ai][bj][m][n] * r; const f32x4 t = v[bj][n]; s += (t[0] * t[0] + t[1] * t[1]) + (t[2] * t[2] + t[3] * t[3]); }
                if (kind != 2) {
                    s += __shfl_xor(s, 16); s += __shfl_xor(s, 32);
                    const float hr = (__builtin_amdgcn_rsqf(s * (1.0f / 64.0f) + 1e-6f)) * (kind == 0 ? QSCALE : 1.0f);
#pragma unroll
                    for (int bj = 0; bj < 2; ++bj)
#pragma unroll
                        for (int n = 0; n < 2; ++n) v[bj][n] = v[bj][n] * hr * gn[bj][n];
                }
#pragma unroll
                for (int bj = 0; bj < 2; ++bj) {
                    u32x4 w; w.x = cvt_pk_bf16(v[bj][0][0], v[bj][0][1]); w.y = cvt_pk_bf16(v[bj][0][2], v[bj][0][3]); w.z = cvt_pk_bf16(v[bj][1][0], v[bj][1][1]); w.w = cvt_pk_bf16(v[bj][1][2], v[bj][1][3]);
                    st_b128(dst + (size_t)row * pitch + 32 * bj + 8 * fq, w);
                }
                if (tail && ai == 1) {
                    const int nb = u.pm >> 4, w = 16 * m + fr + 64 * wr;
                    float* o = fo + ((size_t)(nb * 128 + w)) * 256 + wc * 64 + 8 * fq;
#pragma unroll
                    for (int bj = 0; bj < 2; ++bj) { st_f128(o + 32 * bj, v[bj][0]); st_f128(o + 32 * bj + 4, v[bj][1]); }
                }
            }
    }
};

struct EpiRes {
    float* xout; bf16_t* xb; float* ss;
    __device__ __forceinline__ void operator()(const f32x4 (&acc)[2][2][4][2], const Unit& u, int ui, int wr, int wc, int fr, int fq) const {
        const int rowbase = u.pm * BM + wr * 64, col0 = u.pn * BM + wc * 32 + 8 * fq;
#pragma unroll
        for (int ai = 0; ai < 2; ++ai)
#pragma unroll
            for (int m = 0; m < 4; ++m) {
                const int row = rowbase + 128 * ai + 16 * m + fr; float s = 0.f;
                bf16_t* br = xb + (size_t)row * 1024 + col0;
                u32x4 xin[2];
#pragma unroll
                for (int bj = 0; bj < 2; ++bj) xin[bj] = *(const u32x4*)(br + bj * HALF);
                f32x2 s2 = {0.f, 0.f};
#pragma unroll
                for (int bj = 0; bj < 2; ++bj) {
                    const u32x4 xw = xin[bj];
                    f32x2 p[4]; u32x4 w;
#pragma unroll
                    for (int c = 0; c < 4; ++c) {
                        const unsigned xc = c == 0 ? xw.x : c == 1 ? xw.y : c == 2 ? xw.z : xw.w;
                        const f32x4 a4 = acc[ai][bj][m][c >> 1];
                        const f32x2 xv = {__builtin_bit_cast(float, xc << 16), __builtin_bit_cast(float, xc & 0xffff0000u)};
                        p[c] = (f32x2){a4[2 * (c & 1)], a4[2 * (c & 1) + 1]} + xv;
                        s2 = __builtin_elementwise_fma(p[c], p[c], s2);
                    }
                    w.x = cvt_pk_bf16(p[0].x, p[0].y); w.y = cvt_pk_bf16(p[1].x, p[1].y); w.z = cvt_pk_bf16(p[2].x, p[2].y); w.w = cvt_pk_bf16(p[3].x, p[3].y);
                    st_b128(br + bj * HALF, w);
                    if (xout) { float* xo = xout + (size_t)row * 1024 + col0 + bj * HALF; st_f128(xo, (f32x4){p[0].x, p[0].y, p[1].x, p[1].y}); st_f128(xo + 4, (f32x4){p[2].x, p[2].y, p[3].x, p[3].y}); }
                }
                s = s2.x + s2.y;
                s += __shfl_xor(s, 16); s += __shfl_xor(s, 32);
                if (fq == 0) st_b32(ss + (size_t)row * 32 + 4 * u.pn + wc, s);
                if (m & 1) asm volatile("" ::: "memory");
            }
    }
};

struct EpiGlu {
    bf16_t* xb; float* ss;
    __device__ __forceinline__ void operator()(const f32x4 (&acc)[2][2][4][2], const Unit& u, int ui, int wr, int wc, int fr, int fq) const {
        const int rowbase = u.pm * BM + wr * 64, col0 = u.pn * 128 + wc * 32 + 8 * fq;
#pragma unroll
        for (int ai = 0; ai < 2; ++ai)
#pragma unroll
            for (int m = 0; m < 4; ++m) {
                const int row = rowbase + 128 * ai + 16 * m + fr; float s = 0.f;
                bf16_t* br = xb + (size_t)row * 1024 + col0;
                const u32x4 xw = *(const u32x4*)br;
                f32x2 s2 = {0.f, 0.f}; u32x4 w;
#pragma unroll
                for (int c = 0; c < 4; ++c) {
                    const unsigned xc = c == 0 ? xw.x : c == 1 ? xw.y : c == 2 ? xw.z : xw.w;
                    const f32x4 a4 = acc[ai][0][m][c >> 1], b4 = acc[ai][1][m][c >> 1];
                    const f32x2 a2 = {a4[2 * (c & 1)], a4[2 * (c & 1) + 1]}, b2 = {b4[2 * (c & 1)], b4[2 * (c & 1) + 1]};
                    const f32x2 t2 = b2 * (f32x2){-LOG2E, -LOG2E};
                    const f32x2 d2 = (f32x2){__builtin_amdgcn_exp2f(t2.x), __builtin_amdgcn_exp2f(t2.y)} + (f32x2){1.0f, 1.0f};
                    const f32x2 r2 = {__builtin_amdgcn_rcpf(d2.x), __builtin_amdgcn_rcpf(d2.y)};
                    const f32x2 xv = {__builtin_bit_cast(float, xc << 16), __builtin_bit_cast(float, xc & 0xffff0000u)};
                    const f32x2 o2 = __builtin_elementwise_fma(a2, r2, xv);
                    s2 = __builtin_elementwise_fma(o2, o2, s2);
                    const unsigned wc_ = cvt_pk_bf16(o2.x, o2.y);
                    if (c == 0) w.x = wc_; else if (c == 1) w.y = wc_; else if (c == 2) w.z = wc_; else w.w = wc_;
                }
                s = s2.x + s2.y;
                st_b128(br, w);
                s += __shfl_xor(s, 16); s += __shfl_xor(s, 32);
                if (fq == 0) st_b32(ss + (size_t)row * 32 + 4 * u.pn + wc, s);
            }
    }
};

__device__ __forceinline__ f32x2 gate2(f32x2 g2, f32x2 ug, f32x2 gb, f32x2 g1, f32x2 a1, f32x2 g0, f32x2 a2, f32x2 h2, f32x2 uv, f32x2 hb, f32x2 h1, f32x2 b1, f32x2 h0, f32x2 b2, f32x2 nl2e, f32x2 one2) {
    f32x2 cg = __builtin_elementwise_fma(g2, ug, gb), cv = __builtin_elementwise_fma(h2, uv, hb);
    cg = __builtin_elementwise_fma(g1, a1, cg); cv = __builtin_elementwise_fma(h1, b1, cv);
    cg = __builtin_elementwise_fma(g0, a2, cg); cv = __builtin_elementwise_fma(h0, b2, cv);
    const f32x2 d = (f32x2){__builtin_amdgcn_exp2f(cg.x), __builtin_amdgcn_exp2f(cg.y)} + one2;
    const f32x2 r = {__builtin_amdgcn_rcpf(d.x), __builtin_amdgcn_rcpf(d.y)};
    return (cg * cv) * r;
}
#define PG8_LO2(v) __builtin_shufflevector(v, v, 0, 1)
#define PG8_HI2(v) __builtin_shufflevector(v, v, 2, 3)
struct EpiUp {
    bf16_t* act; float* halo; PG8_LAS const float* rsl; PG8_LAS const float* cvl;
    __device__ __forceinline__ void operator()(const f32x4 (&acc)[2][2][4][2], const Unit& u, int ui, int wr, int wc, int fr, int fq) const {
        const int rowbase = u.pm * BM + wr * 128, j0 = u.pn * 128 + wc * 32 + 8 * fq, blk = 2 * u.pm + wr;
        f32x2 rs[2][4];
#pragma unroll
        for (int ai = 0; ai < 2; ++ai) { const PG8_LAS f32x4* rp = (const PG8_LAS f32x4*)(rsl + 2 * (128 * wr + 8 * fr + 4 * ai)); const f32x4 t0 = rp[0], t1 = rp[1];
            rs[ai][0] = (f32x2){t0[0], t0[1]}; rs[ai][1] = (f32x2){t0[2], t0[3]}; rs[ai][2] = (f32x2){t1[0], t1[1]}; rs[ai][3] = (f32x2){t1[2], t1[3]}; }
        const PG8_LAS float* cv0 = cvl + ui * 1024 + wc * 32 + 8 * fq;
        const f32x2 nl2e = {-LOG2E, -LOG2E}, one2 = {1.0f, 1.0f};
        u32x4 outw[2][4];
#pragma unroll
        for (int n = 0; n < 2; ++n) {
            const int j = j0 + 4 * n;
            const PG8_LAS float* cvn = cv0 + 4 * n;
            const f32x4 g0 = *(const PG8_LAS f32x4*)(cvn), g1 = *(const PG8_LAS f32x4*)(cvn + 128), g2 = *(const PG8_LAS f32x4*)(cvn + 256), gb = *(const PG8_LAS f32x4*)(cvn + 384);
            const f32x4 h0 = *(const PG8_LAS f32x4*)(cvn + 512), h1 = *(const PG8_LAS f32x4*)(cvn + 640), h2 = *(const PG8_LAS f32x4*)(cvn + 768), hb = *(const PG8_LAS f32x4*)(cvn + 896);
            f32x4 ug[2][4], uv[2][4];
#pragma unroll
            for (int ai = 0; ai < 2; ++ai)
#pragma unroll
                for (int m = 0; m < 4; ++m) { const f32x4 ag = acc[ai][0][m][n], av = acc[ai][1][m][n]; const f32x2 r2 = rs[ai][m];
                    const f32x2 gl = (f32x2){ag[0], ag[1]} * r2, gh = (f32x2){ag[2], ag[3]} * r2, vl = (f32x2){av[0], av[1]} * r2, vh = (f32x2){av[2], av[3]} * r2;
                    ug[ai][m] = (f32x4){gl.x, gl.y, gh.x, gh.y}; uv[ai][m] = (f32x4){vl.x, vl.y, vh.x, vh.y}; }
            if (fr == 0) {
#pragma unroll
                for (int m = 0; m < 2; ++m) { float* hp = halo + ((size_t)blk * 4 + m) * 5632 + j; st_f128(hp, ug[0][m]); st_f128(hp + 2816, uv[0][m]); }
            }
            if (fr == 15) {
#pragma unroll
                for (int m = 2; m < 4; ++m) { float* hp = halo + ((size_t)blk * 4 + m) * 5632 + j; st_f128(hp, ug[1][m]); st_f128(hp + 2816, uv[1][m]); }
            }
            f32x4 pg1, pg2, pv1, pv2;
#pragma unroll
            for (int e = 0; e < 4; ++e) { pg1[e] = dpp_shr1(ug[1][3][e]); pg2[e] = dpp_shr1(ug[1][2][e]); pv1[e] = dpp_shr1(uv[1][3][e]); pv2[e] = dpp_shr1(uv[1][2][e]); }
#pragma unroll
            for (int ai = 0; ai < 2; ++ai)
#pragma unroll
                for (int m = 0; m < 4; ++m) {
                    const f32x4 a1 = ai == 0 ? (m == 0 ? pg1 : ug[0][m > 0 ? m - 1 : 0]) : (m == 0 ? ug[0][3] : ug[1][m > 0 ? m - 1 : 0]);
                    const f32x4 a2 = ai == 0 ? (m == 0 ? pg2 : (m == 1 ? pg1 : ug[0][m > 1 ? m - 2 : 0])) : (m == 0 ? ug[0][2] : (m == 1 ? ug[0][3] : ug[1][m > 1 ? m - 2 : 0]));
                    const f32x4 b1 = ai == 0 ? (m == 0 ? pv1 : uv[0][m > 0 ? m - 1 : 0]) : (m == 0 ? uv[0][3] : uv[1][m > 0 ? m - 1 : 0]);
                    const f32x4 b2 = ai == 0 ? (m == 0 ? pv2 : (m == 1 ? pv1 : uv[0][m > 1 ? m - 2 : 0])) : (m == 0 ? uv[0][2] : (m == 1 ? uv[0][3] : uv[1][m > 1 ? m - 2 : 0]));
                    const f32x2 olo = gate2(PG8_LO2(g2), PG8_LO2(ug[ai][m]), PG8_LO2(gb), PG8_LO2(g1), PG8_LO2(a1), PG8_LO2(g0), PG8_LO2(a2), PG8_LO2(h2), PG8_LO2(uv[ai][m]), PG8_LO2(hb), PG8_LO2(h1), PG8_LO2(b1), PG8_LO2(h0), PG8_LO2(b2), nl2e, one2);
                    const f32x2 ohi = gate2(PG8_HI2(g2), PG8_HI2(ug[ai][m]), PG8_HI2(gb), PG8_HI2(g1), PG8_HI2(a1), PG8_HI2(g0), PG8_HI2(a2), PG8_HI2(h2), PG8_HI2(uv[ai][m]), PG8_HI2(hb), PG8_HI2(h1), PG8_HI2(b1), PG8_HI2(h0), PG8_HI2(b2), nl2e, one2);
                    if (n == 0) { outw[ai][m].x = cvt_pk_bf16(olo.x, olo.y); outw[ai][m].y = cvt_pk_bf16(ohi.x, ohi.y); } else { outw[ai][m].z = cvt_pk_bf16(olo.x, olo.y); outw[ai][m].w = cvt_pk_bf16(ohi.x, ohi.y); }
                }
        }
#pragma unroll
        for (int ai = 0; ai < 2; ++ai)
#pragma unroll
            for (int m = 0; m < 4; ++m) { const int row = rowbase + 8 * fr + 4 * ai + m;
                if (!(fr == 0 && ai == 0 && m < 2)) st_b128(act + (size_t)row * 2816 + j0, outw[ai][m]); }
        asm volatile("" ::: "memory");
    }
};
template <class Epi, class Sched, bool ALIGN_EPI = false, bool SP2 = false, bool APERM = false>
__device__ __forceinline__ void gemm_phase(PG8_LAS unsigned char* lds, const Gemm g, const Sched& S, const Epi& E) {
    const int tid = opaque_tid(), wid = __builtin_amdgcn_readfirstlane(tid >> 6), lane = tid & 63, wr = wid >> 2, wc = wid & 3, fr = lane & 15, fq = lane >> 4;
    const int K = g.K, nt = K / BK;
    unsigned voffA[2], voffB[2];
#pragma unroll
    for (int i = 0; i < 2; ++i) { int R, C; stage_rc(tid * 16 + i * 8192, R, C); const int Ra = APERM ? (((R & 64) << 1) | ((R & 15) << 3) | ((R >> 4) & 3)) : R;
        voffA[i] = (unsigned)(Ra * K + C) * 2u; voffB[i] = (unsigned)(R * K + C) * 2u; }
    const size_t kstep = (size_t)(BK * 2);
    const size_t hstep = (size_t)HALF * K * 2;
    const size_t hstepA = APERM ? (size_t)4 * K * 2 : hstep;
    const size_t tstep = 2 * hstep;
    const unsigned ldsw = (unsigned)wid * 1024u;
    const int aoff = lds_byte(wr * 64 + fr, fq * 8), boff = lds_byte(wc * 32 + fr, fq * 8);
#define PG8_SA(b, h) (((b) * 2 + (h)) * HTB)
#define PG8_SB(b, h) ((4 + (b) * 2 + (h)) * HTB)
#define PG8_STAGE(bufoff, gbase, voff) do { _Pragma("unroll") for (int _i = 0; _i < 2; ++_i) \
        __builtin_amdgcn_global_load_lds((const unsigned*)((const char*)(gbase) + (voff)[_i]), (PG8_LAS unsigned*)(lds + (bufoff) + ldsw + _i * 8192), 16, 0, 0); } while (0)
#define PG8_LDA(dst, b, h) do { _Pragma("unroll") for (int m = 0; m < 4; ++m) _Pragma("unroll") for (int k = 0; k < 2; ++k) dst[m][k] = *(const PG8_LAS bf16x8*)(lds + PG8_SA(b, h) + aoff + m * 2048 + k * 1024); } while (0)
#define PG8_LDB(dst, b, h) do { _Pragma("unroll") for (int n = 0; n < 2; ++n) _Pragma("unroll") for (int k = 0; k < 2; ++k) dst[n][k] = *(const PG8_LAS bf16x8*)(lds + PG8_SB(b, h) + boff + n * 2048 + k * 1024); } while (0)
#define PG8_MMA(ai, bj, At, Bt) do { __builtin_amdgcn_s_setprio(1); _Pragma("unroll") for (int m = 0; m < 4; ++m) _Pragma("unroll") for (int n = 0; n < 2; ++n) _Pragma("unroll") for (int k = 0; k < 2; ++k) \
        acc[ai][bj][m][n] = __builtin_amdgcn_mfma_f32_16x16x32_bf16(Bt[n][k], At[m][k], acc[ai][bj][m][n], 0, 0, 0); __builtin_amdgcn_s_setprio(0); } while (0)
#define PG8_WAIT_V(n) asm volatile("s_waitcnt vmcnt(" #n ")" ::: "memory")
#define PG8_WAIT_L(n) asm volatile("s_waitcnt lgkmcnt(" #n ")" ::: "memory")
#define PG8_BAR __builtin_amdgcn_s_barrier()
#define PG8_SCHED __builtin_amdgcn_sched_barrier(0)
    Unit cur, nxt; int ui = 0;
    if (!S.next(0, cur)) return;
    f32x4 acc[2][2][4][2];
#pragma unroll
    for (int a = 0; a < 2; ++a)
#pragma unroll
        for (int b = 0; b < 2; ++b)
#pragma unroll
            for (int m = 0; m < 4; ++m)
#pragma unroll
                for (int n = 0; n < 2; ++n) acc[a][b][m][n] = (f32x4){0.f, 0.f, 0.f, 0.f};
    bf16x8 At[4][2], B0[2][2], B1[2][2];
    const char* cA = (const char*)g.A + (size_t)cur.pm * tstep; const char* cB = (const char*)g.Bt + (size_t)cur.pn * tstep;
    S.a_ready(cur);
    if constexpr (SP2) {
        PG8_STAGE(PG8_SB(0, 0), cB, voffB); PG8_STAGE(PG8_SB(0, 1), cB + hstep, voffB); PG8_STAGE(PG8_SA(0, 0), cA, voffA); PG8_STAGE(PG8_SA(0, 1), cA + hstepA, voffA);
        if (wr == 1) PG8_BAR;
        PG8_WAIT_V(2); PG8_BAR;
        PG8_STAGE(PG8_SB(1, 0), cB + kstep, voffB); PG8_STAGE(PG8_SA(1, 0), cA + kstep, voffA); PG8_STAGE(PG8_SB(1, 1), cB + hstep + kstep, voffB);
        PG8_WAIT_V(6); PG8_BAR;
    } else {
        PG8_STAGE(PG8_SB(0, 0), cB, voffB); PG8_STAGE(PG8_SA(0, 0), cA, voffA); PG8_STAGE(PG8_SB(0, 1), cB + hstep, voffB); PG8_STAGE(PG8_SA(0, 1), cA + hstepA, voffA);
        if (wr == 1) PG8_BAR;
        PG8_WAIT_V(4); PG8_BAR;
        PG8_STAGE(PG8_SB(1, 0), cB + kstep, voffB); PG8_STAGE(PG8_SA(1, 0), cA + kstep, voffA); PG8_STAGE(PG8_SB(1, 1), cB + hstep + kstep, voffB);
        PG8_WAIT_V(6); PG8_BAR;
    }
    for (;;) {
        const bool has_next = S.next(ui + 1, nxt);
        const char* nA = has_next ? (const char*)g.A + (size_t)nxt.pm * tstep : cA; const char* nB = has_next ? (const char*)g.Bt + (size_t)nxt.pn * tstep : cB;
        for (int t = 0; t < nt; t += 2) {
            const bool last = (t == nt - 2);
            const char* a1 = cA + (size_t)(t + 1) * kstep;
            const char* a2 = last ? nA : cA + (size_t)(t + 2) * kstep; const char* b2 = last ? nB : cB + (size_t)(t + 2) * kstep;
            const char* a3 = a2 + kstep; const char* b3 = b2 + kstep;
            if (last && has_next) S.a_ready(nxt);
            if constexpr (SP2) {
            PG8_LDB(B0, 0, 0); PG8_LDB(B1, 0, 1); PG8_SCHED; PG8_LDA(At, 0, 0); PG8_STAGE(PG8_SA(1, 1), a1 + hstepA, voffA);
            PG8_WAIT_V(8); PG8_WAIT_L(0); PG8_BAR; PG8_MMA(0, 0, At, B0); PG8_MMA(0, 1, At, B1); PG8_BAR; PG8_SCHED;
            PG8_LDA(At, 0, 1); PG8_STAGE(PG8_SB(0, 0), b2, voffB); PG8_STAGE(PG8_SB(0, 1), b2 + hstep, voffB); PG8_STAGE(PG8_SA(0, 0), a2, voffA);
            PG8_WAIT_V(8); PG8_WAIT_L(0); PG8_BAR; PG8_MMA(1, 0, At, B0); PG8_MMA(1, 1, At, B1); PG8_BAR; PG8_SCHED;
            PG8_LDB(B0, 1, 0); PG8_LDB(B1, 1, 1); PG8_SCHED; PG8_LDA(At, 1, 0); PG8_STAGE(PG8_SA(0, 1), a2 + hstepA, voffA);
            PG8_WAIT_V(8); PG8_WAIT_L(0); PG8_BAR; PG8_MMA(0, 0, At, B0); PG8_MMA(0, 1, At, B1); PG8_BAR; PG8_SCHED;
            PG8_LDA(At, 1, 1); PG8_STAGE(PG8_SB(1, 0), b3, voffB); PG8_STAGE(PG8_SB(1, 1), b3 + hstep, voffB); PG8_STAGE(PG8_SA(1, 0), a3, voffA);
            PG8_WAIT_V(8); PG8_WAIT_L(0); PG8_BAR; PG8_MMA(1, 0, At, B0); PG8_MMA(1, 1, At, B1); PG8_BAR; PG8_SCHED;
            } else {
            PG8_LDB(B0, 0, 0); PG8_SCHED; PG8_LDA(At, 0, 0); PG8_STAGE(PG8_SA(1, 1), a1 + hstepA, voffA);
            PG8_WAIT_L(8); PG8_BAR; PG8_WAIT_L(0); PG8_MMA(0, 0, At, B0); PG8_BAR; PG8_SCHED;
            PG8_LDB(B1, 0, 1); PG8_STAGE(PG8_SB(0, 0), b2, voffB);
            PG8_BAR; PG8_WAIT_L(0); PG8_MMA(0, 1, At, B1); PG8_BAR;
            PG8_LDA(At, 0, 1); PG8_STAGE(PG8_SA(0, 0), a2, voffA);
            PG8_BAR; PG8_WAIT_L(0); PG8_MMA(1, 0, At, B0); PG8_BAR; PG8_SCHED;
            PG8_STAGE(PG8_SB(0, 1), b2 + hstep, voffB);
            PG8_WAIT_V(6); PG8_BAR; PG8_MMA(1, 1, At, B1); PG8_BAR;
            PG8_LDB(B0, 1, 0); PG8_SCHED; PG8_LDA(At, 1, 0); PG8_STAGE(PG8_SA(0, 1), a2 + hstepA, voffA);
            PG8_WAIT_L(8); PG8_BAR; PG8_WAIT_L(0); PG8_MMA(0, 0, At, B0); PG8_BAR; PG8_SCHED;
            PG8_LDB(B1, 1, 1); PG8_STAGE(PG8_SB(1, 0), b3, voffB);
            PG8_BAR; PG8_WAIT_L(0); PG8_MMA(0, 1, At, B1); PG8_BAR;
            PG8_LDA(At, 1, 1); PG8_STAGE(PG8_SA(1, 0), a3, voffA);
            PG8_BAR; PG8_WAIT_L(0); PG8_MMA(1, 0, At, B0); PG8_BAR; PG8_SCHED;
            PG8_STAGE(PG8_SB(1, 1), b3 + hstep, voffB);
            PG8_WAIT_V(6); PG8_BAR; PG8_MMA(1, 1, At, B1); PG8_BAR;
            }
        }
        if constexpr (ALIGN_EPI) { if (wr == 0) PG8_BAR; }
        {
            E(acc, cur, ui, wr, wc, fr, fq); S.done(cur);
        }
        if (!has_next) break;
#pragma unroll
        for (int a = 0; a < 2; ++a)
#pragma unroll
            for (int b = 0; b < 2; ++b)
#pragma unroll
                for (int m = 0; m < 4; ++m)
#pragma unroll
                    for (int n = 0; n < 2; ++n) acc[a][b][m][n] = (f32x4){0.f, 0.f, 0.f, 0.f};
        cur = nxt; cA = nA; cB = nB; ++ui;
        if constexpr (ALIGN_EPI) { if (wr == 1) PG8_BAR; }
    }
    PG8_WAIT_V(0);
    if constexpr (!ALIGN_EPI) { if (wr == 0) PG8_BAR; }
    PG8_BAR;
#undef PG8_SA
#undef PG8_SB
#undef PG8_STAGE
#undef PG8_LDA
#undef PG8_LDB
#undef PG8_MMA
#undef PG8_WAIT_V
#undef PG8_WAIT_L
#undef PG8_BAR
#undef PG8_SCHED
}
}


namespace att {
using s16x4 = __attribute__((ext_vector_type(4))) short;
using f32x16 = __attribute__((ext_vector_type(16))) float;
using u32x4 = __attribute__((ext_vector_type(4))) unsigned;
typedef LAS const char* lds_cptr;
constexpr int SLOTB = 8192, LDS_K = 0, LDS_V = 4 * SLOTB, LDS_WS = 8 * SLOTB, LDS_OST = LDS_WS + 8 * 256, LDS_BYTES = LDS_OST + 8 * 4096;
__device__ __forceinline__ int crow(int r, int hi) { return (r & 3) + 8 * (r >> 2) + 4 * hi; }
__device__ __forceinline__ void glds16(const void* gsrc, unsigned lds_dst) { unsigned keep;
    asm volatile("s_mov_b32 %0, m0\n\ts_mov_b32 m0, %2\n\ts_nop 0\n\tglobal_load_lds_dwordx4 %1, off\n\ts_mov_b32 m0, %0" : "=&s"(keep) : "v"(gsrc), "s"(lds_dst) : "memory"); }
typedef float f32x2_t __attribute__((ext_vector_type(2))); typedef __bf16 bf16x2_t __attribute__((ext_vector_type(2)));
__device__ __forceinline__ unsigned cvtpk_s(float lo, float hi) { f32x2_t v = {lo, hi}; bf16x2_t b = __builtin_convertvector(v, bf16x2_t); return __builtin_bit_cast(unsigned, b); }
__device__ __forceinline__ void qkt(f32x16& p0, f32x16& p1, lds_cptr kb  , const bf16x8* qr) {
    p0 = f32x16{}; p1 = f32x16{};
#pragma unroll
    for (int d0 = 0; d0 < 4; ++d0) {
        const bf16x8 b0 = *(const LAS bf16x8*)(kb + d0 * 2048);
        const bf16x8 b1 = *(const LAS bf16x8*)(kb + d0 * 2048 + 512);
        p0 = __builtin_amdgcn_mfma_f32_32x32x16_bf16(b0, qr[d0], p0, 0, 0, 0); p1 = __builtin_amdgcn_mfma_f32_32x32x16_bf16(b1, qr[d0], p1, 0, 0, 0); }
}
__device__ __forceinline__ void pv(f32x16* o, int vb, bf16x8 pa0, bf16x8 pa1, bf16x8 pa2, bf16x8 pa3) {
#pragma unroll
    for (int d0 = 0; d0 < 2; ++d0) { s16x4 lo[4], hi[4];
#pragma unroll
        for (int ks = 0; ks < 4; ++ks) {
            asm volatile("ds_read_b64_tr_b16 %0,%1 offset:%c2" : "=&v"(lo[ks]) : "v"(vb), "i"(d0 * 4096 + ks * 1024) : "memory");
            asm volatile("ds_read_b64_tr_b16 %0,%1 offset:%c2" : "=&v"(hi[ks]) : "v"(vb), "i"(d0 * 4096 + ks * 1024 + 512) : "memory"); }
        asm volatile("s_waitcnt lgkmcnt(0)" ::: "memory"); __builtin_amdgcn_sched_barrier(0);
#define ATT_PK(k) (bf16x8){lo[k][0], lo[k][1], lo[k][2], lo[k][3], hi[k][0], hi[k][1], hi[k][2], hi[k][3]}
        o[d0] = __builtin_amdgcn_mfma_f32_32x32x16_bf16(pa0, ATT_PK(0), o[d0], 0, 0, 0);
        o[d0] = __builtin_amdgcn_mfma_f32_32x32x16_bf16(pa1, ATT_PK(1), o[d0], 0, 0, 0);
        o[d0] = __builtin_amdgcn_mfma_f32_32x32x16_bf16(pa2, ATT_PK(2), o[d0], 0, 0, 0);
        o[d0] = __builtin_amdgcn_mfma_f32_32x32x16_bf16(pa3, ATT_PK(3), o[d0], 0, 0, 0);
#undef ATT_PK
    }
}
__device__ __forceinline__ float hswap_max(float m) { auto rr = __builtin_amdgcn_permlane32_swap(__float_as_uint(m), __float_as_uint(m), false, false); return fmaxf(__uint_as_float(rr[0]), __uint_as_float(rr[1])); }
__device__ __forceinline__ float hswap_sum(float m) { auto rr = __builtin_amdgcn_permlane32_swap(__float_as_uint(m), __float_as_uint(m), false, false); return __uint_as_float(rr[0]) + __uint_as_float(rr[1]); }

struct Roll { const f32x4* sk; const f32x4* sv; f32x4* dk; f32x4* dv; };
__device__ __forceinline__ void attn_units4(int n, int qb0, int kv, const bf16* Q, const bf16* __restrict__ K, const bf16* __restrict__ V, bf16* O, const float* __restrict__ sink, LAS char* shm, const Roll rl, int rid0) {
    asm volatile("" : "+s"(n), "+s"(qb0), "+s"(kv));
    const int tid = opaque_tid(), lane = tid & 63, r32 = lane & 31, hi = lane >> 5; const int wid = __builtin_amdgcn_readfirstlane(tid >> 6);
    const int g = wid >> 1, qh = wid & 1, h = kv * 4 + g; const long rowbase = (long)n * SEQ;
    const unsigned lds0 = (unsigned)(uintptr_t)shm;
    LAS float* wsf = (LAS float*)(shm + LDS_WS) + wid * 64;
    const bf16* kbase = K + (rowbase + lane) * 256 + kv * 64 + wid * 8;
    const bf16* vbase = V + (rowbase + 16 * (wid & 3) + (lane >> 2)) * 256 + kv * 64 + (wid >> 2) * 32 + (lane & 3) * 8;
    const bf16* Qw = Q + (rowbase + qh * 32 + r32) * 1024 + h * 64 + hi * 8;
    bf16* Ow = O + (rowbase + qh * 32) * 1024 + h * 64;
    LAS bf16* stg = (LAS bf16*)(shm + LDS_OST) + wid * 2048;
    const float sk2 = sink[h] * LOG2E;
#define ATT_TILE(kt) do { const int kt_ = (kt); if (kt_ >= 0) { const int so_ = (kt_ & 3) * SLOTB + wid * 1024; \
        glds16(kbase + (long)kt_ * 64 * 256, (unsigned)__builtin_amdgcn_readfirstlane(lds0 + LDS_K + so_)); glds16(vbase + (long)kt_ * 64 * 256, (unsigned)__builtin_amdgcn_readfirstlane(lds0 + LDS_V + so_)); } } while (0)
    ATT_TILE(qb0 - 2); ATT_TILE(qb0 - 1); ATT_TILE(qb0);
    bf16x8 qr[4], qn[4];
#pragma unroll
    for (int d0 = 0; d0 < 4; ++d0) { qr[d0] = *reinterpret_cast<const bf16x8*>(Qw + (long)qb0 * 64 * 1024 + d0 * 16); qn[d0] = qr[d0]; }
    f32x4 ck0 = {}, ck1 = {}, cv0 = {}, cv1 = {}; size_t cd0 = 0, cd1 = 0; bool c0 = false, c1 = false, pend = false;
#pragma unroll 1
    for (int i = 0; i < 4; ++i) {
        const int qb = qb0 + i;
        asm volatile("s_waitcnt vmcnt(0) lgkmcnt(0)\n\ts_barrier" ::: "memory");
        if (i < 3) { ATT_TILE(qb + 1);
#pragma unroll
            for (int d0 = 0; d0 < 4; ++d0) qn[d0] = *reinterpret_cast<const bf16x8*>(Qw + (long)(qb + 1) * 64 * 1024 + d0 * 16); }
        if (pend) {
#pragma unroll
            for (int j = 0; j < 4; ++j) { const int row = j * 8 + (lane >> 3), ch = lane & 7; const u32x4 v = *(const LAS u32x4*)(stg + row * 64 + ch * 8); *(u32x4*)(Ow + ((long)(qb - 1) * 64 + row) * 1024 + ch * 8) = v; }
            if (c0) { rl.dk[cd0] = ck0; rl.dv[cd0] = cv0; }
            if (c1) { rl.dk[cd1] = ck1; rl.dv[cd1] = cv1; }
            asm volatile("s_waitcnt lgkmcnt(0)" ::: "memory"); }
        c0 = false; c1 = false;
        if (rid0 >= 0) { const int e0 = (rid0 + i) * 512 + tid, e1 = e0 + 1024 * 512;
            c0 = true; { const int nn = e0 / (127 * 64); cd0 = (size_t)nn * 128 * 64 + (e0 - nn * (127 * 64)); ck0 = rl.sk[cd0 + 64]; cv0 = rl.sv[cd0 + 64]; }
            c1 = e1 < 128 * 127 * 64; if (c1) { const int nn = e1 / (127 * 64); cd1 = (size_t)nn * 128 * 64 + (e1 - nn * (127 * 64)); ck1 = rl.sk[cd1 + 64]; cv1 = rl.sv[cd1 + 64]; } }
        const int jlo = qb == 0 ? 2 : (qb == 1 ? 1 : 0);
        const int s0 = ((qb - 2) & 3) * SLOTB, s1 = ((qb - 1) & 3) * SLOTB, s2 = (qb & 3) * SLOTB;
        const lds_cptr kp0 = (lds_cptr)shm + LDS_K + hi * 1024 + r32 * 16;
        const int vb0 = (int)(lds0 + LDS_V) + ((lane >> 4) & 1) * 32 + (lane & 3) * 8 + (4 * hi + ((lane & 15) >> 2)) * 64;
        const float NEG = -INFINITY;
        f32x16 p00, p01, p10, p11, p20, p21;
        if (jlo <= 0) qkt(p00, p01, kp0 + s0, qr); else { for (int r = 0; r < 16; ++r) { p00[r] = NEG; p01[r] = NEG; } }
        if (jlo <= 1) qkt(p10, p11, kp0 + s1, qr); else { for (int r = 0; r < 16; ++r) { p10[r] = NEG; p11[r] = NEG; } }
        qkt(p20, p21, kp0 + s2, qr);
        const int qrel = qh * 32 + r32;
#pragma unroll
        for (int r = 0; r < 16; ++r) { const int kk = crow(r, hi);
            if (kk < qrel + 1) p00[r] = NEG; if (kk + 32 < qrel + 1) p01[r] = NEG;
            if (kk > qrel) p20[r] = NEG; if (kk + 32 > qrel) p21[r] = NEG; }
        float mx = sk2;
#pragma unroll
        for (int r = 0; r < 16; ++r) { mx = fmaxf(fmaxf(mx, p00[r]), p01[r]); mx = fmaxf(fmaxf(mx, p10[r]), p11[r]); mx = fmaxf(fmaxf(mx, p20[r]), p21[r]); }
        mx = hswap_max(mx);
        f32x2_t ls2 = {0.f, 0.f}; const f32x2_t mx2 = {mx, mx};
#define ATT_EXP2(P) do { _Pragma("unroll") for (int r = 0; r < 16; r += 2) { const f32x2_t d_ = (f32x2_t){P[r], P[r + 1]} - mx2; \
            const f32x2_t e_ = {__builtin_amdgcn_exp2f(d_.x), __builtin_amdgcn_exp2f(d_.y)}; P[r] = e_.x; P[r + 1] = e_.y; ls2 += e_; } } while (0)
        ATT_EXP2(p00); ATT_EXP2(p01); ATT_EXP2(p10); ATT_EXP2(p11); ATT_EXP2(p20); ATT_EXP2(p21);
#undef ATT_EXP2
        float ls = ls2.x + ls2.y;
        ls = hswap_sum(ls) + __builtin_amdgcn_exp2f(sk2 - mx);
        f32x16 o[2]; o[0] = f32x16{}; o[1] = f32x16{};
#define ATT_PKW(P, B) cvtpk_s(P[B], P[B + 1])
#define ATT_PVT(PA, PB, SO) do { const u32x4 w0 = (u32x4){ATT_PKW(PA, 0), ATT_PKW(PA, 2), ATT_PKW(PA, 4), ATT_PKW(PA, 6)}, w1 = (u32x4){ATT_PKW(PA, 8), ATT_PKW(PA, 10), ATT_PKW(PA, 12), ATT_PKW(PA, 14)}, \
        w2 = (u32x4){ATT_PKW(PB, 0), ATT_PKW(PB, 2), ATT_PKW(PB, 4), ATT_PKW(PB, 6)}, w3 = (u32x4){ATT_PKW(PB, 8), ATT_PKW(PB, 10), ATT_PKW(PB, 12), ATT_PKW(PB, 14)}; \
        pv(o, vb0 + (SO), __builtin_bit_cast(bf16x8, w0), __builtin_bit_cast(bf16x8, w1), __builtin_bit_cast(bf16x8, w2), __builtin_bit_cast(bf16x8, w3)); } while (0)
        if (jlo <= 0) ATT_PVT(p00, p01, s0);
        if (jlo <= 1) ATT_PVT(p10, p11, s1);
        ATT_PVT(p20, p21, s2);
#undef ATT_PVT
#undef ATT_PKW
        if (hi == 0) wsf[32 + r32] = ls; asm volatile("s_waitcnt lgkmcnt(0)" ::: "memory");
        float rli[16];
#pragma unroll
        for (int r = 0; r < 16; ++r) rli[r] = __builtin_amdgcn_rcpf(wsf[32 + crow(r, hi)]);
#pragma unroll
        for (int r = 0; r < 16; ++r) { const int orow = crow(r, hi);
#pragma unroll
            for (int d0 = 0; d0 < 2; ++d0) stg[orow * 64 + d0 * 32 + r32] = (bf16)f2bf(o[d0][r] * rli[r]); }
        pend = true;
#pragma unroll
        for (int d0 = 0; d0 < 4; ++d0) qr[d0] = qn[d0];
    }
#undef ATT_TILE
    asm volatile("s_waitcnt lgkmcnt(0)" ::: "memory");
#pragma unroll
    for (int j = 0; j < 4; ++j) { const int row = j * 8 + (lane >> 3), ch = lane & 7; const u32x4 v = *(const LAS u32x4*)(stg + row * 64 + ch * 8); *(u32x4*)(Ow + ((long)(qb0 + 3) * 64 + row) * 1024 + ch * 8) = v; }
    if (c0) { rl.dk[cd0] = ck0; rl.dv[cd0] = cv0; }
    if (c1) { rl.dk[cd1] = ck1; rl.dv[cd1] = cv1; }
    asm volatile("s_waitcnt lgkmcnt(0)\n\ts_barrier" ::: "memory");
}
}
namespace ssm {
using f32x16 = __attribute__((ext_vector_type(16))) float;
using s16x4 = __attribute__((ext_vector_type(4))) short;
constexpr int XT_PITCH = 144, XT_BYTES = 128 * XT_PITCH, WREG = XT_BYTES + 256;
constexpr size_t T_AB = 0, T_BBT = 32768, T_CCT = T_BBT + 262144, T_DG = T_CCT + 262144, T_BYTES = 1u << 20;
__device__ __forceinline__ float fma_s(float a, float b, float c) { float r; asm("v_fma_f32 %0, %1, %2, %3" : "=v"(r) : "v"(a), "v"(b), "v"(c)); return r; }
__device__ __forceinline__ float mul_s(float a, float b) { float r; asm("v_mul_f32_e32 %0, %1, %2" : "=v"(r) : "v"(a), "v"(b)); return r; }
__device__ __forceinline__ float cstep(float p_, float a, float q, float b, float s_, float d) { float r; asm("v_mul_f32_e32 %0, %5, %6\n\tv_fma_f32 %0, %3, %4, %0\n\tv_fma_f32 %0, %1, %2, %0" : "=&v"(r) : "v"(p_), "v"(a), "v"(q), "v"(b), "v"(s_), "v"(d)); return r; }
__device__ __forceinline__ void cstep4(float& x0r, float& x0i, float& x1r, float& x1i, float a0x, float a0y, float na0y, float a1x, float a1y, float na1y, float s_, float d0_, float d2_, float d1_, float d3_) {
    float n0r, n0i, n1r, n1i;
    asm("v_mul_f32_e32 %0, %14, %15\n\tv_mul_f32_e32 %1, %14, %16\n\tv_mul_f32_e32 %2, %14, %17\n\tv_mul_f32_e32 %3, %14, %18\n\t"
        "v_fma_f32 %0, %6, %11, %0\n\tv_fma_f32 %1, %5, %10, %1\n\tv_fma_f32 %2, %9, %13, %2\n\tv_fma_f32 %3, %8, %12, %3\n\t"
        "v_fma_f32 %0, %4, %10, %0\n\tv_fma_f32 %1, %4, %11, %1\n\tv_fma_f32 %2, %7, %12, %2\n\tv_fma_f32 %3, %7, %13, %3"
        : "=&v"(n0r), "=&v"(n0i), "=&v"(n1r), "=&v"(n1i)
        : "v"(a0x), "v"(a0y), "v"(na0y), "v"(a1x), "v"(a1y), "v"(na1y), "v"(x0r), "v"(x0i), "v"(x1r), "v"(x1i), "v"(s_), "v"(d0_), "v"(d2_), "v"(d1_), "v"(d3_));
    x0r = n0r; x0i = n0i; x1r = n1r; x1i = n1i;
}
__device__ __forceinline__ int tokmap(int T, int i) { return 32 * ((i >> 2) & 1) + 16 * T + 4 * (i >> 3) + (i & 3); }

struct Tab { const float* ab; const bf16* bbt; const bf16* cct; const float* dg; };
__device__ __forceinline__ Tab tab_of(unsigned char* ws, int jm) { unsigned char* b = ws + WS_SSM + (size_t)jm * T_BYTES; return Tab{(const float*)(b + T_AB), (const bf16*)(b + T_BBT), (const bf16*)(b + T_CCT), (const float*)(b + T_DG)}; }

__device__ __forceinline__ void build_tables(unsigned char* ws, int jm, int gp, const float* a_re, const float* a_im, const float* log_dt, const float* b_re, const float* b_im,
                                             const float* c_re, const float* c_im, const float* dsk, const float* gain) {
    unsigned char* b = ws + WS_SSM + (size_t)jm * T_BYTES;
    float* AB = (float*)(b + T_AB); bf16* BBT = (bf16*)(b + T_BBT); bf16* CCT = (bf16*)(b + T_CCT); float* DG = (float*)(b + T_DG);
    const int g = gp >> 6, p = gp & 63;
    const float dt = expf(log_dt[g]), ar = a_re[gp], ai = a_im[gp];
    const float mag = expf(ar * dt); float sn, cs; sincosf(ai * dt, &sn, &cs);
    const float abr = mag * cs, abi = mag * sn, den = ar * ar + ai * ai;
    const float cr = ((abr - 1.0f) * ar + abi * ai) / den, ci = (abi * ar - (abr - 1.0f) * ai) / den;
    *(float2*)(AB + 2 * gp) = make_float2(abr, abi);
    const float4* br4 = (const float4*)(b_re + (size_t)gp * 16); const float4* bi4 = (const float4*)(b_im + (size_t)gp * 16); const float4* gn4 = (const float4*)(gain + g * 16);
    uint4* dre = (uint4*)(BBT + ((size_t)g * 128 + p) * 16); uint4* dim = (uint4*)(BBT + ((size_t)g * 128 + 64 + p) * 16);
#pragma unroll
    for (int h = 0; h < 2; ++h) {
        const float4 r0 = br4[2 * h], r1 = br4[2 * h + 1], i0 = bi4[2 * h], i1 = bi4[2 * h + 1], g0 = gn4[2 * h], g1 = gn4[2 * h + 1];
        uint4 vr, vi;
        vr.x = pk2((cr * r0.x - ci * i0.x) * g0.x, (cr * r0.y - ci * i0.y) * g0.y); vr.y = pk2((cr * r0.z - ci * i0.z) * g0.z, (cr * r0.w - ci * i0.w) * g0.w);
        vr.z = pk2((cr * r1.x - ci * i1.x) * g1.x, (cr * r1.y - ci * i1.y) * g1.y); vr.w = pk2((cr * r1.z - ci * i1.z) * g1.z, (cr * r1.w - ci * i1.w) * g1.w);
        vi.x = pk2((cr * i0.x + ci * r0.x) * g0.x, (cr * i0.y + ci * r0.y) * g0.y); vi.y = pk2((cr * i0.z + ci * r0.z) * g0.z, (cr * i0.w + ci * r0.w) * g0.w);
        vi.z = pk2((cr * i1.x + ci * r1.x) * g1.x, (cr * i1.y + ci * r1.y) * g1.y); vi.w = pk2((cr * i1.z + ci * r1.z) * g1.z, (cr * i1.w + ci * r1.w) * g1.w);
        dre[h] = vr; dim[h] = vi;
    }
    for (int c = 0; c < 16; ++c) {
        CCT[((size_t)g * 16 + c) * 128 + p] = (bf16)f2bf(c_re[((size_t)g * 16 + c) * 64 + p]);
        CCT[((size_t)g * 16 + c) * 128 + 64 + p] = (bf16)f2bf(-c_im[((size_t)g * 16 + c) * 64 + p]);
    }
    if (p < 16) DG[g * 16 + p] = dsk[g * 16 + p] * gain[g * 16 + p];
}

template <bool FINAL>
__device__ __forceinline__ void unit(int n, int chunk, const Tab T, const bf16* __restrict__ XB, const float* __restrict__ SS, f32x2* __restrict__ EC, bf16* __restrict__ Z, LAS unsigned char* L) {
    const int tid = opaque_tid(), lane = tid & 63, r32 = lane & 31, hi = lane >> 5; const int wave = __builtin_amdgcn_readfirstlane(tid >> 6);
    LAS unsigned char* wl = L + wave * WREG; LAS float* rsb = (LAS float*)(wl + XT_BYTES);
    const int row0 = n * SEQ + chunk * 64;
    { const f32x4* p = (const f32x4*)(SS + (size_t)(row0 + lane) * 32); float s = 0.f;
#pragma unroll
      for (int i = 0; i < 4; ++i) { const f32x4 t = p[i]; s += (t[0] + t[1]) + (t[2] + t[3]); }
      rsb[lane] = __builtin_amdgcn_rsqf(s * (1.0f / 1024.0f) + 1e-6f); }
    LDS_WAIT(); asm volatile("" ::: "memory");
    const int run = 2 * chunk + hi;
    bf16x8 a_n[2], b_n[4]; f32x2 A0_n, A1_n, c0_n = {0.f, 0.f}, c1_n = {0.f, 0.f};
#define SSM_LOAD(G) do { _Pragma("unroll") for (int t = 0; t < 2; ++t) a_n[t] = *(const bf16x8*)(XB + (size_t)(row0 + tokmap(t, r32)) * 1024 + (G) * 16 + 8 * hi); \
        _Pragma("unroll") for (int cb = 0; cb < 4; ++cb) b_n[cb] = *(const bf16x8*)(T.bbt + ((size_t)(G) * 128 + 32 * cb + r32) * 16 + 8 * hi); \
        A0_n = *(const f32x2*)(T.ab + 2 * ((G) * 64 + r32)); A1_n = *(const f32x2*)(T.ab + 2 * ((G) * 64 + 32 + r32)); \
        if (FINAL) { const f32x2* ec_ = EC + ((size_t)(n * 128 + run) * 64 + (G)) * 64; c0_n = ec_[r32]; c1_n = ec_[32 + r32]; } } while (0)
    SSM_LOAD(wave * 8);
#pragma unroll 1
    for (int gi = 0; gi < 8; ++gi) {
        const int g = wave * 8 + gi;
        bf16x8 a[2], b[4];
#pragma unroll
        for (int t = 0; t < 2; ++t) a[t] = a_n[t];
#pragma unroll
        for (int cb = 0; cb < 4; ++cb) b[cb] = b_n[cb];
        const f32x2 A0 = A0_n, A1 = A1_n; const f32x2 c0 = c0_n, c1 = c1_n;
        v2u xwc[4]; bf16x8 ca[4];
        if (FINAL) {
#pragma unroll
            for (int tt = 0; tt < 4; ++tt) { xwc[tt] = *(const v2u*)(XB + (size_t)(row0 + 16 * tt + (lane & 15)) * 1024 + g * 16 + 4 * (lane >> 4)); ca[tt] = *(const bf16x8*)(T.cct + ((size_t)g * 16 + (lane & 15)) * 128 + 32 * tt + 8 * (lane >> 4)); }
        }
        if (gi < 7) SSM_LOAD(g + 1);
        float x0r = c0.x, x0i = c0.y, x1r = c1.x, x1i = c1.y;
        f32x2* ec = EC + ((size_t)(n * 128 + run) * 64 + g) * 64;
#pragma unroll
        for (int t = 0; t < 2; ++t) {
            float rs[16];
#pragma unroll
            for (int k = 0; k < 4; ++k) { const f32x4 tq = *(const LAS f32x4*)(rsb + 32 * hi + 16 * t + 4 * k); rs[4 * k] = tq[0]; rs[4 * k + 1] = tq[1]; rs[4 * k + 2] = tq[2]; rs[4 * k + 3] = tq[3]; }
            const f32x16 z16 = f32x16{};
            f32x16 d0 = __builtin_amdgcn_mfma_f32_32x32x16_bf16(a[t], b[0], z16, 0, 0, 0), d1 = __builtin_amdgcn_mfma_f32_32x32x16_bf16(a[t], b[1], z16, 0, 0, 0);
            f32x16 d2 = __builtin_amdgcn_mfma_f32_32x32x16_bf16(a[t], b[2], z16, 0, 0, 0), d3 = __builtin_amdgcn_mfma_f32_32x32x16_bf16(a[t], b[3], z16, 0, 0, 0);
            asm volatile("s_nop 15\n\ts_nop 7" : "+v"(d0), "+v"(d1), "+v"(d2), "+v"(d3));
            const float nA0y = -A0.y, nA1y = -A1.y;
#pragma unroll
            for (int hf = 0; hf < 2; ++hf) {
                float o0r[8], o0i[8], o1r[8], o1i[8];
#pragma unroll
                for (int r8 = 0; r8 < 8; ++r8) {
                    const int r = 8 * hf + r8; const float s = rs[r];
                    cstep4(x0r, x0i, x1r, x1i, A0.x, A0.y, nA0y, A1.x, A1.y, nA1y, s, d0[r], d2[r], d1[r], d3[r]);
                    const float n0r = x0r, n0i = x0i, n1r = x1r, n1i = x1i;
                    if (FINAL) { o0r[r8] = n0r; o0i[r8] = n0i; o1r[r8] = n1r; o1i[r8] = n1i; }
                }
                if (FINAL) {
                    const int cofs = (32 * hi + 16 * t + 8 * hf) * 2;
                    v4u w0, w1, w2, w3;
                    w0.x = pg8::cvt_pk_bf16(o0r[0], o0r[1]); w0.y = pg8::cvt_pk_bf16(o0r[2], o0r[3]); w0.z = pg8::cvt_pk_bf16(o0r[4], o0r[5]); w0.w = pg8::cvt_pk_bf16(o0r[6], o0r[7]);
                    w1.x = pg8::cvt_pk_bf16(o1r[0], o1r[1]); w1.y = pg8::cvt_pk_bf16(o1r[2], o1r[3]); w1.z = pg8::cvt_pk_bf16(o1r[4], o1r[5]); w1.w = pg8::cvt_pk_bf16(o1r[6], o1r[7]);
                    w2.x = pg8::cvt_pk_bf16(o0i[0], o0i[1]); w2.y = pg8::cvt_pk_bf16(o0i[2], o0i[3]); w2.z = pg8::cvt_pk_bf16(o0i[4], o0i[5]); w2.w = pg8::cvt_pk_bf16(o0i[6], o0i[7]);
                    w3.x = pg8::cvt_pk_bf16(o1i[0], o1i[1]); w3.y = pg8::cvt_pk_bf16(o1i[2], o1i[3]); w3.z = pg8::cvt_pk_bf16(o1i[4], o1i[5]); w3.w = pg8::cvt_pk_bf16(o1i[6], o1i[7]);
                    *(LAS v4u*)(wl + (r32) * XT_PITCH + cofs) = w0; *(LAS v4u*)(wl + (32 + r32) * XT_PITCH + cofs) = w1;
                    *(LAS v4u*)(wl + (64 + r32) * XT_PITCH + cofs) = w2; *(LAS v4u*)(wl + (96 + r32) * XT_PITCH + cofs) = w3;
                    asm volatile("s_nop 1" ::: "memory"); __builtin_amdgcn_sched_barrier(0);
                }
            }
        }
        if (!FINAL) { const f32x2 e0 = {x0r, x0i}, e1 = {x1r, x1i}; pg8::st_b64(ec + r32, __builtin_bit_cast(v2u, e0)); pg8::st_b64(ec + 32 + r32, __builtin_bit_cast(v2u, e1)); }
        else {
            LDS_WAIT(); asm volatile("" ::: "memory");
            const int i16 = lane & 15, kq = lane >> 4;
            const f32x4 dg = *(const f32x4*)(T.dg + g * 16 + 4 * kq);
            const unsigned trb = (unsigned)(uintptr_t)wl + (8 * kq + (i16 >> 2)) * XT_PITCH + (4 * (i16 & 3)) * 2;
            s16x4 lo[4][4], hh[4][4];
#pragma unroll
            for (int tt = 0; tt < 4; ++tt)
#pragma unroll
                for (int ks = 0; ks < 4; ++ks) {
                    asm volatile("ds_read_b64_tr_b16 %0,%1 offset:%c2" : "=&v"(lo[tt][ks]) : "v"(trb), "i"(ks * 32 * XT_PITCH + tt * 32) : "memory");
                    asm volatile("ds_read_b64_tr_b16 %0,%1 offset:%c2" : "=&v"(hh[tt][ks]) : "v"(trb), "i"(ks * 32 * XT_PITCH + 4 * XT_PITCH + tt * 32) : "memory"); }
            asm volatile("s_waitcnt lgkmcnt(0)" ::: "memory"); __builtin_amdgcn_sched_barrier(0);
            f32x4 acc4[4];
#pragma unroll
            for (int tt = 0; tt < 4; ++tt) acc4[tt] = (f32x4){0.f, 0.f, 0.f, 0.f};
#pragma unroll
            for (int ks = 0; ks < 4; ++ks)
#pragma unroll
                for (int tt = 0; tt < 4; ++tt) { const bf16x8 bb = (bf16x8){lo[tt][ks][0], lo[tt][ks][1], lo[tt][ks][2], lo[tt][ks][3], hh[tt][ks][0], hh[tt][ks][1], hh[tt][ks][2], hh[tt][ks][3]};
                    acc4[tt] = __builtin_amdgcn_mfma_f32_16x16x32_bf16(ca[ks], bb, acc4[tt], 0, 0, 0); }
#pragma unroll
            for (int tt = 0; tt < 4; ++tt) {
                const f32x4 acc = acc4[tt];
                const int tok = 16 * tt + i16; const size_t row = (size_t)(row0 + tok);
                const v2u xw = xwc[tt];
                const float rt = rsb[tok];
                const float h0 = __builtin_bit_cast(float, xw.x << 16), h1 = __builtin_bit_cast(float, xw.x & 0xffff0000u), h2 = __builtin_bit_cast(float, xw.y << 16), h3 = __builtin_bit_cast(float, xw.y & 0xffff0000u);
                const f32x2 dr0 = {dg[0] * rt, dg[1] * rt}, dr1 = {dg[2] * rt, dg[3] * rt};
                f32x2 ya = (f32x2){acc[0], acc[1]} + dr0 * (f32x2){h0, h1}, yb = (f32x2){acc[2], acc[3]} + dr1 * (f32x2){h2, h3};
                const f32x2 ua = (ya * ya * 0.044715f + 1.0f) * ya * (-1.5957691216057308f * LOG2E), ub = (yb * yb * 0.044715f + 1.0f) * yb * (-1.5957691216057308f * LOG2E);
                f32x2 ea, eb; ea.x = __builtin_amdgcn_exp2f(ua.x); ea.y = __builtin_amdgcn_exp2f(ua.y); eb.x = __builtin_amdgcn_exp2f(ub.x); eb.y = __builtin_amdgcn_exp2f(ub.y);
                ea = ea + 1.0f; eb = eb + 1.0f;
                f32x2 ra, rb; ra.x = __builtin_amdgcn_rcpf(ea.x); ra.y = __builtin_amdgcn_rcpf(ea.y); rb.x = __builtin_amdgcn_rcpf(eb.x); rb.y = __builtin_amdgcn_rcpf(eb.y);
                ya = ya * ra; yb = yb * rb;
                v2u zw; zw.x = pg8::cvt_pk_bf16(ya.x, ya.y); zw.y = pg8::cvt_pk_bf16(yb.x, yb.y);
                pg8::st_b64(Z + row * 1024 + g * 16 + 4 * kq, zw);
            }
            LDS_WAIT(); asm volatile("" ::: "memory");
        }
    }
}

__device__ __forceinline__ void carries(int vcu, int G, const Tab T, const f32x2* __restrict__ E, f32x2* __restrict__ CIN, float* __restrict__ out_re, float* __restrict__ out_im) {
    const int tid = opaque_tid(), lane = tid & 63, j = lane >> 3;
    for (int wv = vcu * 8 + (tid >> 6); wv < 2048; wv += G * 8) {
        const int Lb = wv * 8 + (lane & 7), n = Lb >> 12, gp = Lb & 4095;
        f32x2 A = *(const f32x2*)(T.ab + 2 * gp);
#pragma unroll
        for (int s = 0; s < 5; ++s) A = f32x2{A.x * A.x - A.y * A.y, 2.f * A.x * A.y};
        f32x2 loc[16]; f32x2 c = {0.f, 0.f};
        const f32x2* e = E + ((size_t)(n * 128 + 16 * j)) * 4096 + gp;
#pragma unroll
        for (int k = 0; k < 16; ++k) { loc[k] = c; const f32x2 ev = e[(size_t)k * 4096]; c = f32x2{A.x * c.x - A.y * c.y + ev.x, A.x * c.y + A.y * c.x + ev.y}; }
        f32x2 P = A;
#pragma unroll
        for (int s = 0; s < 4; ++s) P = f32x2{P.x * P.x - P.y * P.y, 2.f * P.x * P.y};
        f32x2 carry = {0.f, 0.f}, mine = {0.f, 0.f};
#pragma unroll
        for (int i = 0; i < 8; ++i) { const float er = __shfl(c.x, (lane & 7) + 8 * i), ei = __shfl(c.y, (lane & 7) + 8 * i); if (i == j) mine = carry;
            carry = f32x2{P.x * carry.x - P.y * carry.y + er, P.x * carry.y + P.y * carry.x + ei}; }
        if (j == 0) { out_re[(size_t)n * 4096 + gp] = carry.x; out_im[(size_t)n * 4096 + gp] = carry.y; }
        f32x2 pw = {1.f, 0.f}; f32x2* o = CIN + ((size_t)(n * 128 + 16 * j)) * 4096 + gp;
#pragma unroll
        for (int k = 0; k < 16; ++k) { o[(size_t)k * 4096] = f32x2{loc[k].x + pw.x * mine.x - pw.y * mine.y, loc[k].y + pw.x * mine.y + pw.y * mine.x}; pw = f32x2{pw.x * A.x - pw.y * A.y, pw.x * A.y + pw.y * A.x}; }
    }
}
#undef SSM_LOAD
}
namespace sg {
constexpr size_t WS_SSS = WS_SSM + 34 * MiB;
constexpr size_t WS_QKVS = WS_SSS + 65536;
enum { M_QKV = 0, M_RES = 1, M_GLU = 2, M_UP = 3 };
struct P { float* x; bf16* xb; float* sss; float* qkvs; bf16* act; const float* cw; const float* cb; const float* stc; float* cso; };
__device__ __forceinline__ float rs_of(const float* sss, int t) { const f32x4* p = (const f32x4*)(sss + t * 64); float s = 0.f;
#pragma unroll
    for (int i = 0; i < 16; ++i) { const f32x4 v = p[i]; s += (v[0] + v[1]) + (v[2] + v[3]); }
    return 1.0f / sqrtf(s * (1.0f / 1024.0f) + 1e-6f); }
__device__ __forceinline__ float rs_of4(const float* sss, int t, int kq) { const f32x4* p = (const f32x4*)(sss + t * 64 + 16 * kq); float s = 0.f;
#pragma unroll
    for (int i = 0; i < 4; ++i) { const f32x4 v = p[i]; s += (v[0] + v[1]) + (v[2] + v[3]); }
    s += __shfl_xor(s, 16); s += __shfl_xor(s, 32);
    return 1.0f / sqrtf(s * (1.0f / 1024.0f) + 1e-6f); }
template <int MODE, int KK, int NT>
__device__ __forceinline__ void unit(int uu, const bf16* __restrict__ Xs, const bf16* __restrict__ Wt, const P p, LAS unsigned char* L) {
    constexpr bool PAIRED = (MODE == M_GLU || MODE == M_UP);
    constexpr int NTG = 8 / NT, NKS = KK / 256;
    const int u = uu / NTG, tg = uu % NTG;
    const int tid = opaque_tid(), lane = tid & 63, i16 = lane & 15, kq = lane >> 4; const int wave = __builtin_amdgcn_readfirstlane(tid >> 6);
    const int rA = PAIRED ? (256 * (u >> 3) + 16 * (u & 7)) : 16 * u;
    const bf16* wa = Wt + (size_t)(rA + i16) * KK + wave * (KK / 8) + 8 * kq;
    const bf16* xa = Xs + (size_t)(16 * NT * tg + i16) * KK + wave * (KK / 8) + 8 * kq;
    const int tE = 16 * (NT * tg + (wave < NT ? wave : 0)) + i16;
    const int cE = MODE == M_RES ? 256 * (u >> 4) + 128 * ((u >> 3) & 1) + 32 * ((u >> 1) & 3) + 4 * (u & 1) + 8 * kq : 128 * (u >> 3) + 32 * ((u & 7) >> 1) + 4 * (u & 1) + 8 * kq;
    f32x4 pre0 = (f32x4){0.f, 0.f, 0.f, 0.f}, pre1 = pre0, pre2 = pre0, pre3 = pre0; float preR = 0.f;
    if (wave < NT) {
        if (MODE == M_RES || MODE == M_GLU) pre0 = *(const f32x4*)(p.x + (size_t)tE * 1024 + cE);
        if (MODE == M_UP) { const float* s0 = p.stc + (size_t)tE * 2 * 5632;
            pre0 = *(const f32x4*)(s0 + cE); pre1 = *(const f32x4*)(s0 + 5632 + cE); pre2 = *(const f32x4*)(s0 + 2816 + cE); pre3 = *(const f32x4*)(s0 + 5632 + 2816 + cE); preR = rs_of4(p.sss, tE, kq); }
    }
    f32x4 acc[NT], accB[NT];
#pragma unroll
    for (int m = 0; m < NT; ++m) { acc[m] = (f32x4){0.f, 0.f, 0.f, 0.f}; accB[m] = (f32x4){0.f, 0.f, 0.f, 0.f}; }
    bf16x8 wf[NKS], wg[NKS];
#pragma unroll
    for (int ks = 0; ks < NKS; ++ks) { wf[ks] = *(const bf16x8*)(wa + 32 * ks); if (PAIRED) wg[ks] = *(const bf16x8*)(wa + (size_t)128 * KK + 32 * ks); }
    constexpr int MB = (NKS <= 4) ? (NT >= 4 ? 4 : NT) : (NT * NKS <= 24 ? NT : 1);
#pragma unroll
    for (int m0 = 0; m0 < NT; m0 += MB) {
        bf16x8 xf[MB][NKS];
#pragma unroll
        for (int mm = 0; mm < MB; ++mm)
#pragma unroll
            for (int ks = 0; ks < NKS; ++ks) xf[mm][ks] = *(const bf16x8*)(xa + (size_t)(16 * (m0 + mm)) * KK + 32 * ks);
#pragma unroll
        for (int mm = 0; mm < MB; ++mm)
#pragma unroll
            for (int ks = 0; ks < NKS; ++ks) { acc[m0 + mm] = __builtin_amdgcn_mfma_f32_16x16x32_bf16(wf[ks], xf[mm][ks], acc[m0 + mm], 0, 0, 0);
                if (PAIRED) accB[m0 + mm] = __builtin_amdgcn_mfma_f32_16x16x32_bf16(wg[ks], xf[mm][ks], accB[m0 + mm], 0, 0, 0); }
    }
    LAS f32x4* red = (LAS f32x4*)L;
#pragma unroll
    for (int m = 0; m < NT; ++m) { red[(wave * NT + m) * 64 + lane] = acc[m]; if (PAIRED) red[4096 + (wave * NT + m) * 64 + lane] = accB[m]; }
    __syncthreads();
    if (wave < NT) {
    f32x4 ta = (f32x4){0.f, 0.f, 0.f, 0.f}, tb = (f32x4){0.f, 0.f, 0.f, 0.f};
#pragma unroll
    for (int v = 0; v < 8; ++v) { ta += red[(v * NT + wave) * 64 + lane]; if (PAIRED) tb += red[4096 + (v * NT + wave) * 64 + lane]; }
    const int t = 16 * (NT * tg + wave) + i16;
    if (MODE == M_QKV) {
        const int n0 = 256 * (u >> 4) + 64 * ((u >> 1) & 3) + 32 * ((u >> 3) & 1) + 4 * (u & 1) + 8 * kq;
        *(f32x4*)(p.qkvs + (size_t)t * 1536 + n0) = ta * rs_of4(p.sss, t, kq);
    } else if (MODE == M_RES || MODE == M_GLU) {
        const int c = (MODE == M_RES ? 256 * (u >> 4) + 128 * ((u >> 3) & 1) + 32 * ((u >> 1) & 3) + 4 * (u & 1) : 128 * (u >> 3) + 32 * ((u & 7) >> 1) + 4 * (u & 1)) + 8 * kq;
        float* xr = p.x + (size_t)t * 1024 + c; f32x4 o = pre0;
        if (MODE == M_RES) o += ta;
        else {
#pragma unroll
            for (int e = 0; e < 4; ++e) o[e] += ta[e] * __builtin_amdgcn_rcpf(1.0f + __builtin_amdgcn_exp2f(-LOG2E * tb[e])); }
        *(f32x4*)xr = o; v2u w; w.x = pk2(o[0], o[1]); w.y = pk2(o[2], o[3]); *(v2u*)(p.xb + (size_t)t * 1024 + c) = w;
        float s = (o[0] * o[0] + o[1] * o[1]) + (o[2] * o[2] + o[3] * o[3]); s += __shfl_xor(s, 16); s += __shfl_xor(s, 32);
        if (kq == 0) p.sss[t * 64 + u] = s;
    } else {
        const int j = 128 * (u >> 3) + 32 * ((u & 7) >> 1) + 4 * (u & 1) + 8 * kq;
        const float r = preR;
        const f32x4 ug = ta * r, uv = tb * r;
        const float* s0 = p.stc + (size_t)t * 2 * 5632; float* so = p.cso + (size_t)t * 2 * 5632;
        const f32x4 b0g = pre0, b1g = pre1, b0v = pre2, b1v = pre3;
        const f32x4 cg = *(const f32x4*)(p.cb + j) + *(const f32x4*)(p.cw + j) * b0g + *(const f32x4*)(p.cw + 5632 + j) * b1g + *(const f32x4*)(p.cw + 2 * 5632 + j) * ug;
        const f32x4 cv = *(const f32x4*)(p.cb + 2816 + j) + *(const f32x4*)(p.cw + 2816 + j) * b0v + *(const f32x4*)(p.cw + 5632 + 2816 + j) * b1v + *(const f32x4*)(p.cw + 2 * 5632 + 2816 + j) * uv;
        f32x4 o;
#pragma unroll
        for (int e = 0; e < 4; ++e) o[e] = cg[e] * __builtin_amdgcn_rcpf(1.0f + __builtin_amdgcn_exp2f(-LOG2E * cg[e])) * cv[e];
        v2u w; w.x = pk2(o[0], o[1]); w.y = pk2(o[2], o[3]); *(v2u*)(p.act + (size_t)t * 2816 + j) = w;
        *(f32x4*)(so + j) = b1g; *(f32x4*)(so + 2816 + j) = b1v; *(f32x4*)(so + 5632 + j) = ug; *(f32x4*)(so + 5632 + 2816 + j) = uv;
    }
    }
    __syncthreads();
}

__device__ __forceinline__ void attn_pairs(int pid0, const float* __restrict__ qkvs, const float* __restrict__ ck, const float* __restrict__ cv, const float* __restrict__ qg, const float* __restrict__ kg,
                                           const float* __restrict__ sink, bf16* __restrict__ o, float* __restrict__ kso, float* __restrict__ vso, LAS unsigned char* L) {
    const int tid = opaque_tid(), lane = tid & 63; const int wave = __builtin_amdgcn_readfirstlane(tid >> 6);
    const int slot = wave >> 2, g = wave & 3, pid = pid0 + slot, n = pid >> 2, kv = pid & 3, h = kv * 4 + g;
    const int kk = lane >> 2, dq = lane & 3;
    LAS unsigned char* Kl = L + slot * 65536; LAS unsigned char* Vl = Kl + 32768;
    { const unsigned kb = (unsigned)(uintptr_t)Kl + (32 * g) * 256, vb = (unsigned)(uintptr_t)Vl + (32 * g) * 256;
#pragma unroll
      for (int i = 0; i < 8; ++i) { int r = 32 * g + 4 * i + (lane >> 4); r = r < 127 ? r + 1 : 127;
          const size_t off = ((size_t)(n * 128 + r) * 4 + kv) * 64 + (lane & 15) * 4;
          att::glds16(ck + off, (unsigned)__builtin_amdgcn_readfirstlane(kb + i * 1024)); att::glds16(cv + off, (unsigned)__builtin_amdgcn_readfirstlane(vb + i * 1024)); } }
    const float* row = qkvs + (size_t)n * 1536;
    f32x4 q[4], kn[4], vn[4]; float sq = 0.f, sk = 0.f;
#pragma unroll
    for (int i = 0; i < 4; ++i) { q[i] = *(const f32x4*)(row + h * 64 + 16 * dq + 4 * i); kn[i] = *(const f32x4*)(row + 1024 + kv * 64 + 16 * dq + 4 * i); vn[i] = *(const f32x4*)(row + 1280 + kv * 64 + 16 * dq + 4 * i);
        sq += (q[i][0] * q[i][0] + q[i][1] * q[i][1]) + (q[i][2] * q[i][2] + q[i][3] * q[i][3]); sk += (kn[i][0] * kn[i][0] + kn[i][1] * kn[i][1]) + (kn[i][2] * kn[i][2] + kn[i][3] * kn[i][3]); }
    sq += __shfl_xor(sq, 1); sq += __shfl_xor(sq, 2); sk += __shfl_xor(sk, 1); sk += __shfl_xor(sk, 2);
    const float rq = (1.0f / sqrtf(sq * (1.0f / 64.0f) + 1e-6f)) * QSCALE, rk = 1.0f / sqrtf(sk * (1.0f / 64.0f) + 1e-6f);
#pragma unroll
    for (int i = 0; i < 4; ++i) { q[i] = q[i] * rq * *(const f32x4*)(qg + 16 * dq + 4 * i); kn[i] = kn[i] * rk * *(const f32x4*)(kg + 16 * dq + 4 * i); }
    asm volatile("s_waitcnt vmcnt(0)" ::: "memory");
    if (g == 3 && kk == 0) {
#pragma unroll
        for (int i = 0; i < 4; ++i) { *(LAS f32x4*)(Kl + 127 * 256 + dq * 64 + i * 16) = kn[i]; *(LAS f32x4*)(Vl + 127 * 256 + dq * 64 + i * 16) = vn[i]; } }
    asm volatile("s_waitcnt lgkmcnt(0)\n\ts_barrier" ::: "memory");
    float sc[8];
#pragma unroll
    for (int ps = 0; ps < 8; ++ps) { const LAS unsigned char* kr = Kl + (16 * ps + kk) * 256 + dq * 64; float a = 0.f;
#pragma unroll
        for (int i = 0; i < 4; ++i) { const f32x4 kf = *(const LAS f32x4*)(kr + i * 16); a += (q[i][0] * kf[0] + q[i][1] * kf[1]) + (q[i][2] * kf[2] + q[i][3] * kf[3]); }
        a += __shfl_xor(a, 1); a += __shfl_xor(a, 2); sc[ps] = a; }
    const float sk2 = sink[h] * LOG2E;
    float mx = sk2;
#pragma unroll
    for (int ps = 0; ps < 8; ++ps) mx = fmaxf(mx, sc[ps]);
#pragma unroll
    for (int of = 4; of < 64; of <<= 1) mx = fmaxf(mx, __shfl_xor(mx, of));
    float ls = 0.f;
#pragma unroll
    for (int ps = 0; ps < 8; ++ps) { sc[ps] = __builtin_amdgcn_exp2f(sc[ps] - mx); ls += sc[ps]; }
#pragma unroll
    for (int of = 4; of < 64; of <<= 1) ls += __shfl_xor(ls, of);
    ls += __builtin_amdgcn_exp2f(sk2 - mx);
    f32x4 acc[4];
#pragma unroll
    for (int i = 0; i < 4; ++i) acc[i] = (f32x4){0.f, 0.f, 0.f, 0.f};
#pragma unroll
    for (int ps = 0; ps < 8; ++ps) { const LAS unsigned char* vr = Vl + (16 * ps + kk) * 256 + dq * 64;
#pragma unroll
        for (int i = 0; i < 4; ++i) acc[i] += *(const LAS f32x4*)(vr + i * 16) * sc[ps]; }
    const float inv = 1.0f / ls;
#pragma unroll
    for (int i = 0; i < 4; ++i)
#pragma unroll
        for (int e = 0; e < 4; ++e) { float v = acc[i][e]; v += __shfl_xor(v, 4); v += __shfl_xor(v, 8); v += __shfl_xor(v, 16); v += __shfl_xor(v, 32); acc[i][e] = v * inv; }
    if (kk == 0) {
#pragma unroll
        for (int i = 0; i < 4; ++i) { v2u w; w.x = pk2(acc[i][0], acc[i][1]); w.y = pk2(acc[i][2], acc[i][3]); *(v2u*)(o + (size_t)n * 1024 + h * 64 + 16 * dq + 4 * i) = w; }
    }
    if (g == 3 && kk == 0) { const size_t off = ((size_t)(n * 128 + 127) * 4 + kv) * 64 + 16 * dq;
#pragma unroll
        for (int i = 0; i < 4; ++i) { *(f32x4*)(kso + off + 4 * i) = kn[i]; *(f32x4*)(vso + off + 4 * i) = vn[i]; } }
    asm volatile("s_waitcnt lgkmcnt(0)\n\ts_barrier" ::: "memory");
}

__device__ __forceinline__ void ssm_step2(const int (&n)[2], const int (&g)[2], const ssm::Tab T, const float* __restrict__ x, const float* __restrict__ sss, const float* __restrict__ h0r, const float* __restrict__ h0i,
                                          bf16* __restrict__ z, float* __restrict__ out_re, float* __restrict__ out_im, LAS f32x2* xs, int lane) {
    const int c = lane & 15, pq = lane >> 4;
    float r[2], uc[2], dgc[2], nr[2], ni[2]; bf16x8 cr0[2], cr1[2], ci0[2], ci1[2];
#pragma unroll
    for (int k = 0; k < 2; ++k) {
        r[k] = rs_of(sss, n[k]);
        const float* xr = x + (size_t)n[k] * 1024 + g[k] * 16;
        float u[16];
#pragma unroll
        for (int i = 0; i < 4; ++i) { const f32x4 v = *(const f32x4*)(xr + 4 * i); u[4 * i] = v[0]; u[4 * i + 1] = v[1]; u[4 * i + 2] = v[2]; u[4 * i + 3] = v[3]; }
        const bf16x8* br = (const bf16x8*)(T.bbt + ((size_t)g[k] * 128 + lane) * 16); const bf16x8* bi = (const bf16x8*)(T.bbt + ((size_t)g[k] * 128 + 64 + lane) * 16);
        const bf16x8* cr = (const bf16x8*)(T.cct + ((size_t)g[k] * 16 + c) * 128 + 16 * pq); const bf16x8* ci = (const bf16x8*)(T.cct + ((size_t)g[k] * 16 + c) * 128 + 64 + 16 * pq);
        cr0[k] = cr[0]; cr1[k] = cr[1]; ci0[k] = ci[0]; ci1[k] = ci[1];
        uc[k] = xr[c]; dgc[k] = T.dg[g[k] * 16 + c];
        float bur = 0.f, bui = 0.f;
#pragma unroll
        for (int hh = 0; hh < 2; ++hh) { const bf16x8 a = br[hh], b = bi[hh];
#pragma unroll
            for (int e = 0; e < 8; ++e) { bur += u[8 * hh + e] * bf2f((unsigned short)a[e]); bui += u[8 * hh + e] * bf2f((unsigned short)b[e]); } }
        const f32x2 A = *(const f32x2*)(T.ab + 2 * (g[k] * 64 + lane));
        const size_t si = ((size_t)n[k] * 64 + g[k]) * 64 + lane;
        const float sr = h0r[si], sim = h0i[si];
        nr[k] = A.x * sr - A.y * sim + r[k] * bur; ni[k] = A.x * sim + A.y * sr + r[k] * bui;
        out_re[si] = nr[k]; out_im[si] = ni[k];
        xs[64 * k + lane] = f32x2{nr[k], ni[k]};
    }
    LDS_WAIT(); asm volatile("" ::: "memory");
#pragma unroll
    for (int k = 0; k < 2; ++k) {
        float y = 0.f;
#pragma unroll
        for (int q2 = 0; q2 < 8; ++q2) { const f32x4 q = *(const LAS f32x4*)(xs + 64 * k + 16 * pq + 2 * q2);
            const int e0 = 2 * q2, e1 = 2 * q2 + 1;
            const float c0r = bf2f((unsigned short)(e0 < 8 ? cr0[k][e0] : cr1[k][e0 - 8])), c0i = bf2f((unsigned short)(e0 < 8 ? ci0[k][e0] : ci1[k][e0 - 8]));
            const float c1r = bf2f((unsigned short)(e1 < 8 ? cr0[k][e1] : cr1[k][e1 - 8])), c1i = bf2f((unsigned short)(e1 < 8 ? ci0[k][e1] : ci1[k][e1 - 8]));
            y += q[0] * c0r + q[1] * c0i + q[2] * c1r + q[3] * c1i; }
        y += __shfl_xor(y, 16); y += __shfl_xor(y, 32);
        if (lane < 16) {
            const float yy = y + dgc[k] * r[k] * uc[k];
            const float u2 = 1.5957691216057308f * (yy + 0.044715f * yy * yy * yy);
            z[(size_t)n[k] * 1024 + g[k] * 16 + lane] = (bf16)f2bf(yy * __builtin_amdgcn_rcpf(1.0f + __builtin_amdgcn_exp2f(-LOG2E * u2)));
        }
    }
    LDS_WAIT(); asm volatile("" ::: "memory");
}
}
#define XB_TMO      128
#define XB_XCNT(j)  (256  + 64 * (j))
#define XB_XSUB(j)  (1280 + 64 * (j))
#define XB_XGEN(j)  (2304 + 64 * (j))
#define XB_TOP      3328
#define XB_TOPGEN   3392
#define XCD_BAR_WORDS 3456
#define XB_SPIN_CAP (1u << 18)

__device__ __forceinline__ unsigned xb_ld(unsigned* p)              { return __hip_atomic_load(p, __ATOMIC_RELAXED, __HIP_MEMORY_SCOPE_AGENT); }
__device__ __forceinline__ unsigned xb_add(unsigned* p, unsigned v) { return __hip_atomic_fetch_add(p, v, __ATOMIC_RELAXED, __HIP_MEMORY_SCOPE_AGENT); }
__device__ __forceinline__ unsigned xb_xcc_id() { return (unsigned)__builtin_amdgcn_s_getreg((3 << 11) | 20) & 0xFu; }
#define XB_SPIN(cond, bar) do { unsigned _sp = 0; while (cond) { __builtin_amdgcn_s_sleep(1); \
    if ((++_sp & 255u) == 0u) { if (xb_ld(&(bar)[XB_TMO])) break; if (_sp > XB_SPIN_CAP) { atomicAdd(&(bar)[XB_TMO], 1u); break; } } } } while (0)

struct XcdBarrier {
    unsigned* bar; unsigned x;
    volatile LAS unsigned* st;
};

__device__ __forceinline__ XcdBarrier xcd_barrier_post(unsigned* bar, volatile LAS unsigned* st) {
    XcdBarrier b; b.bar = bar; b.x = xb_xcc_id(); b.st = st;
    if (threadIdx.x == 0) (void)xb_add(&bar[XB_XCNT(b.x)], 1u);
    return b;
}
__device__ __forceinline__ void xcd_barrier_complete(unsigned* bar, unsigned x, unsigned& nloc, unsigned& nx) {
    const unsigned G = gridDim.x * gridDim.y * gridDim.z;
    unsigned sum, cnt, mine, sp = 0u;
    for (;;) {
        sum = 0u; cnt = 0u; mine = 0u;
#pragma unroll
        for (unsigned j = 0; j < 16; ++j) { const unsigned c = xb_ld(&bar[XB_XCNT(j)]); sum += c; cnt += (c > 0u) ? 1u : 0u; mine = (j == x) ? c : mine; }
        if (sum == G) break;
        __builtin_amdgcn_s_sleep(1);
        if ((++sp & 255u) == 0u) { if (xb_ld(&bar[XB_TMO])) break; if (sp > XB_SPIN_CAP) { atomicAdd(&bar[XB_TMO], 1u); break; } }
    }
    nloc = mine > 0u ? mine : 1u; nx = cnt > 0u ? cnt : 1u;
}

__device__ __forceinline__ void xcd_barrier(const XcdBarrier& b) {
    asm volatile("s_waitcnt vmcnt(0)" ::: "memory");
    __syncthreads();
    if (threadIdx.x == 0) {
        unsigned* bar = b.bar;
        __builtin_amdgcn_s_waitcnt(0);
        unsigned nloc = b.st[0], nx = b.st[1];
        if (nloc == 0u) { xcd_barrier_complete(bar, b.x, nloc, nx); b.st[0] = nloc; b.st[1] = nx; }
        const unsigned old = xb_add(&bar[XB_XSUB(b.x)], 1u);
        const unsigned gen = old / nloc;
        if (old + 1u == (gen + 1u) * nloc) {
            __builtin_amdgcn_fence(__ATOMIC_RELEASE, "agent");
            asm volatile("s_waitcnt vmcnt(0)" ::: "memory");
            const unsigned og = xb_add(&bar[XB_TOP], 1u);
            const unsigned tg = og / nx;
            if (og + 1u == (tg + 1u) * nx) xb_add(&bar[XB_TOPGEN], 1u);
            else XB_SPIN(xb_ld(&bar[XB_TOPGEN]) == tg, bar);
            __builtin_amdgcn_fence(__ATOMIC_ACQUIRE, "agent");
            xb_add(&bar[XB_XGEN(b.x)], 1u);
            asm volatile("s_waitcnt vmcnt(0)" ::: "memory");
        } else {
            XB_SPIN(xb_ld(&bar[XB_XGEN(b.x)]) == gen, bar);
            __builtin_amdgcn_fence(__ATOMIC_ACQUIRE, "agent");
            asm volatile("s_waitcnt vmcnt(0)" ::: "memory");
        }
    }
    __syncthreads();
}


constexpr int NWAVES = 8;
constexpr int RING_BYTES = 131072;
constexpr int LDS_BYTES = 163840;
constexpr int LDSCTL_OFF = LDS_BYTES - 1024, MISC_OFF = LDSCTL_OFF + 320;
static_assert(8 * ssm::WREG <= LDSCTL_OFF && RING_BYTES <= LDSCTL_OFF, "LDS map");
enum Kind { K_PRO = 0, K_QKV, K_ATT, K_WO, K_S1, K_S2, K_S3, K_GLU, K_UP, K_DN };
constexpr int N_PHASES = 23;
__host__ __device__ __forceinline__ void phase_decode(int ph, int& layer, int& kind) {
    if (ph == 0) { layer = 0; kind = K_PRO; return; }
    const int q = ph - 1, pair = q / 11, r = q % 11;
    if (r < 5) { layer = 2 * pair; kind = r == 0 ? K_QKV : r == 1 ? K_ATT : r == 2 ? K_WO : r == 3 ? K_UP : K_DN; }
    else { layer = 2 * pair + 1; const int s = r - 5; kind = s == 0 ? K_S1 : s == 1 ? K_S2 : s == 2 ? K_S3 : s == 3 ? K_GLU : s == 4 ? K_UP : K_DN; }
}

struct Args {
    const float* in[27]; float* out; unsigned char* ws; int ph_lo, ph_hi, li, pad;
};

struct RM_ID  { __device__ __forceinline__ int operator()(int n) const { return n; } };
struct RM_QKV { __device__ __forceinline__ int operator()(int n) const { const int pn = n >> 8, l = n & 255, wc = l >> 6, d = l & 63, bj = d >> 5, fq = (d >> 3) & 3, nn = (d >> 2) & 1, e = d & 3; return (pn << 8) + 128 * bj + 32 * wc + 16 * nn + 4 * fq + e; } };
struct RM_GLU { __device__ __forceinline__ int operator()(int n) const { const int half = n >> 10, c = n & 1023, l = c & 127, wc = l >> 5, fq = (l >> 3) & 3, nn = (l >> 2) & 1, e = l & 3; return ((c >> 7) << 8) + 128 * half + 32 * wc + 16 * nn + 4 * fq + e; } };
struct RM_RES { __device__ __forceinline__ int operator()(int n) const { const int l = n & 31, fq = (l >> 3) & 3, nn = (l >> 2) & 1, e = l & 3; return (n & ~31) + 16 * nn + 4 * fq + e; } };
struct RM_UP  { __device__ __forceinline__ int operator()(int n) const { const int half = n >= 2816 ? 1 : 0, j = n - 2816 * half, pn = j >> 7, l = j & 127, wc = l >> 5, fq = (l >> 3) & 3, nn = (l >> 2) & 1, e = l & 3; return (pn << 8) + 128 * half + 32 * wc + 16 * nn + 4 * fq + e; } };

template <class RM>
__device__ __forceinline__ void transpose_item(const float* __restrict__ W, int K, int N, bf16* __restrict__ WT, const float* __restrict__ gain, LAS float* scr, int item, int lane, RM rm) {
    const int nblk = N / 32, kb = item / nblk, nb = item % nblk, k0 = 64 * kb, n0 = 32 * nb;
    const int kr = lane >> 3, n4 = (lane & 7) * 4;
    f32x4 v[8];
#pragma unroll
    for (int i = 0; i < 8; ++i) v[i] = *(const f32x4*)(W + (size_t)(k0 + 8 * i + kr) * N + n0 + n4);
#pragma unroll
    for (int i = 0; i < 8; ++i) { const float gk = gain ? gain[k0 + 8 * i + kr] : 1.0f; *(LAS f32x4*)(scr + (8 * i + kr) * 36 + n4) = v[i] * gk; }
    LDS_WAIT(); asm volatile("" ::: "memory");
    const int c = lane & 7;
#pragma unroll
    for (int j = 0; j < 4; ++j) { const int n = (lane >> 3) + 8 * j; const LAS float* s = scr + (8 * c) * 36 + n;
        v4u o; o.x = pk2(s[0 * 36], s[1 * 36]); o.y = pk2(s[2 * 36], s[3 * 36]); o.z = pk2(s[4 * 36], s[5 * 36]); o.w = pk2(s[6 * 36], s[7 * 36]);
        *(GAS v4u*)(WT + (size_t)rm(n0 + n) * K + k0 + 8 * c) = o; }
    LDS_WAIT(); asm volatile("" ::: "memory");
}
__device__ __forceinline__ void x_row_init(const float* __restrict__ src, float* xdst, bf16* __restrict__ xb, float* __restrict__ ssr, int nslots, int lane) {
    const GAS f32x4* xr = (const GAS f32x4*)src + lane; f32x4 v[4]; float s = 0.f;
#pragma unroll
    for (int j = 0; j < 4; ++j) { v[j] = xr[64 * j]; s += (v[j].x * v[j].x + v[j].y * v[j].y) + (v[j].z * v[j].z + v[j].w * v[j].w); }
    s = wave_sum(s);
#pragma unroll
    for (int j = 0; j < 4; ++j) { if (xdst) ((GAS f32x4*)xdst + lane)[64 * j] = v[j]; ((GAS unsigned long long*)xb + lane)[64 * j] = (unsigned long long)pk2(v[j].x, v[j].y) | ((unsigned long long)pk2(v[j].z, v[j].w) << 32); }
    if (lane < nslots) ssr[lane] = lane == 0 ? s : 0.f;
}

__device__ __forceinline__ void x_rows2_init(const float* __restrict__ s0, const float* __restrict__ s1, bf16* __restrict__ b0, bf16* __restrict__ b1, float* __restrict__ q0, float* __restrict__ q1, int lane) {
    const GAS f32x4* x0 = (const GAS f32x4*)s0 + lane; const GAS f32x4* x1 = (const GAS f32x4*)s1 + lane; f32x4 v[4], w[4]; float sa = 0.f, sb = 0.f;
#pragma unroll
    for (int j = 0; j < 4; ++j) { v[j] = x0[64 * j]; w[j] = x1[64 * j]; }
#pragma unroll
    for (int j = 0; j < 4; ++j) { sa += (v[j].x * v[j].x + v[j].y * v[j].y) + (v[j].z * v[j].z + v[j].w * v[j].w); sb += (w[j].x * w[j].x + w[j].y * w[j].y) + (w[j].z * w[j].z + w[j].w * w[j].w); }
    sa = wave_sum(sa); sb = wave_sum(sb);
#pragma unroll
    for (int j = 0; j < 4; ++j) { ((GAS unsigned long long*)b0 + lane)[64 * j] = (unsigned long long)pk2(v[j].x, v[j].y) | ((unsigned long long)pk2(v[j].z, v[j].w) << 32);
                                  ((GAS unsigned long long*)b1 + lane)[64 * j] = (unsigned long long)pk2(w[j].x, w[j].y) | ((unsigned long long)pk2(w[j].z, w[j].w) << 32); }
    if (lane < 16) { q0[lane] = lane == 0 ? sa : 0.f; q1[lane] = lane == 0 ? sb : 0.f; }
}

__device__ __forceinline__ void ffn_fixup(int pm, bool write_conv, const float* __restrict__ halo, const float* __restrict__ cw, const float* __restrict__ cb, bf16* __restrict__ act, float* __restrict__ conv_out) {
    const int tid = opaque_tid();
    for (int j = 4 * tid; j < 2816; j += 4 * 512) {
        f32x4 w0[2], w1[2], w2[2], bb[2];
#pragma unroll
        for (int hf = 0; hf < 2; ++hf) { const int c = j + 2816 * hf; w0[hf] = *(const f32x4*)(cw + c); w1[hf] = *(const f32x4*)(cw + 5632 + c); w2[hf] = *(const f32x4*)(cw + 2 * 5632 + c); bb[hf] = *(const f32x4*)(cb + c); }
        f32x4 H0[2][2], H1[2][2], P2[2][2], P3[2][2];
#pragma unroll
        for (int b = 0; b < 2; ++b) {
            const int blk = 2 * pm + b; const bool first = (blk & 31) == 0;
            const float* h0 = halo + (size_t)blk * 4 * 5632; const float* hp = halo + (size_t)(first ? blk : blk - 1) * 4 * 5632;
#pragma unroll
            for (int hf = 0; hf < 2; ++hf) { const int c = j + 2816 * hf; H0[b][hf] = *(const f32x4*)(h0 + c); H1[b][hf] = *(const f32x4*)(h0 + 5632 + c);
                P2[b][hf] = *(const f32x4*)(hp + 2 * 5632 + c); P3[b][hf] = *(const f32x4*)(hp + 3 * 5632 + c);
                if (first) { P2[b][hf] = (f32x4){0.f, 0.f, 0.f, 0.f}; P3[b][hf] = (f32x4){0.f, 0.f, 0.f, 0.f}; } }
        }
#pragma unroll
        for (int b = 0; b < 2; ++b) {
            const int blk = 2 * pm + b;
            const f32x4 g0 = bb[0] + w2[0] * H0[b][0] + w1[0] * P3[b][0] + w0[0] * P2[b][0], v0 = bb[1] + w2[1] * H0[b][1] + w1[1] * P3[b][1] + w0[1] * P2[b][1];
            const f32x4 g1 = bb[0] + w2[0] * H1[b][0] + w1[0] * H0[b][0] + w0[0] * P3[b][0], v1 = bb[1] + w2[1] * H1[b][1] + w1[1] * H0[b][1] + w0[1] * P3[b][1];
            f32x4 o0, o1;
#pragma unroll
            for (int e = 0; e < 4; ++e) { o0[e] = g0[e] * __builtin_amdgcn_rcpf(1.0f + __builtin_amdgcn_exp2f(-LOG2E * g0[e])) * v0[e]; o1[e] = g1[e] * __builtin_amdgcn_rcpf(1.0f + __builtin_amdgcn_exp2f(-LOG2E * g1[e])) * v1[e]; }
            v2u q0, q1; q0.x = pk2(o0[0], o0[1]); q0.y = pk2(o0[2], o0[3]); q1.x = pk2(o1[0], o1[1]); q1.y = pk2(o1[2], o1[3]);
            *(v2u*)(act + (size_t)(128 * blk) * 2816 + j) = q0; *(v2u*)(act + (size_t)(128 * blk + 1) * 2816 + j) = q1;
        }
    }
    if (write_conv && (pm & 15) == 15) {
        const int blk = 2 * pm + 1, n = pm >> 4; const float* h0 = halo + (size_t)blk * 4 * 5632;
        for (int c = 4 * tid; c < 2 * 5632; c += 4 * 512) *(f32x4*)(conv_out + (size_t)n * 2 * 5632 + c) = *(const f32x4*)(h0 + 2 * 5632 + c);
    }
}

constexpr int XL_RS = RING_BYTES, XL_CV = RING_BYTES + 6 * 1024;
static_assert(XL_CV + 6 * 4096 <= LDSCTL_OFF, "spare LDS");
template <bool APERM_UNUSED, bool CONV>
__device__ __forceinline__ void prestage(LAS unsigned char* L, const pg8::StaticOrder& S, const float* __restrict__ ss, int np4, const float* __restrict__ cw, const float* __restrict__ cb) {
    const int tid = opaque_tid(), l8 = tid & 7;
    pg8::Unit u[6]; bool ok[6];
#pragma unroll
    for (int i = 0; i < 6; ++i) ok[i] = S.next(i, u[i]);
    f32x4 rt[6][4], tv[6];
#pragma unroll
    for (int i = 0; i < 6; ++i) {
#pragma unroll
        for (int k = 0; k < 4; ++k) rt[i][k] = (f32x4){0.f, 0.f, 0.f, 0.f};
        tv[i] = (f32x4){0.f, 0.f, 0.f, 0.f};
        if (ok[i]) {
            if (l8 < np4) {
#pragma unroll
                for (int k = 0; k < 4; ++k) rt[i][k] = *(const f32x4*)(ss + (size_t)(u[i].pm * 256 + 64 * k + (tid >> 3)) * 32 + 4 * l8); }
            if (CONV && tid < 256) { const int a = tid >> 5, j = u[i].pn * 128 + 4 * (tid & 31);
                const float* src = (a & 3) == 3 ? cb + j : cw + (size_t)(a & 3) * 5632 + j;
                tv[i] = *(const f32x4*)(src + (a >> 2) * 2816); }
        }
    }
#pragma unroll
    for (int i = 0; i < 6; ++i) if (ok[i]) {
#pragma unroll
        for (int k = 0; k < 4; ++k) { const int row = 64 * k + (tid >> 3);
            float sm = (rt[i][k][0] + rt[i][k][1]) + (rt[i][k][2] + rt[i][k][3]);
            sm += __shfl_xor(sm, 1); sm += __shfl_xor(sm, 2); sm += __shfl_xor(sm, 4);
            const float rsv = __builtin_amdgcn_rsqf(sm * (1.0f / 1024.0f) + 1e-6f);
            if (CONV) { if (u[i].pm != u[0].pm) __builtin_trap();
                        if (l8 == 0 && i == 0) ((LAS f32x2*)(L + XL_RS))[row] = (f32x2){rsv, rsv}; }
            else if (l8 == 0) ((LAS float*)(L + XL_RS))[i * 256 + row] = rsv; }
        if (CONV && tid < 256) { const int a = tid >> 5; *(LAS f32x4*)(L + XL_CV + i * 4096 + a * 512 + (tid & 31) * 16) = tv[i] * (a < 4 ? -LOG2E : -0.6931471805599453f); }
    }
    __syncthreads();
}

__device__ __forceinline__ void convert_layer(const Args& args, unsigned char* ws, int layer, int gw, int ngw, LAS float* scr, int lane) {
    constexpr int I_QKV = 16 * 48, I_WO = 16 * 32, I_GLU = 16 * 64, I_UP = 16 * 176, I_DN = 44 * 32;
    const int jm = layer >> 1; const bool swa = (layer & 1) == 0;
    const int n_mix = swa ? I_QKV + I_WO : I_GLU, n_all = n_mix + I_UP + I_DN;
    for (int it = gw; it < n_all; it += ngw) {
        int r = it;
        if (r < n_mix) {
            if (swa) { if (r < I_QKV) transpose_item(args.in[9] + (size_t)jm * 1024 * 1536, 1024, 1536, (bf16*)(ws + WS_WQKV) + (size_t)jm * 1536 * 1024, args.in[7] + (size_t)layer * 1024, scr, r, lane, RM_QKV());
                       else transpose_item(args.in[10] + (size_t)jm * 1024 * 1024, 1024, 1024, (bf16*)(ws + WS_WO) + (size_t)jm * 1024 * 1024, nullptr, scr, r - I_QKV, lane, RM_RES()); }
            else transpose_item(args.in[22] + (size_t)jm * 1024 * 2048, 1024, 2048, (bf16*)(ws + WS_WGLU) + (size_t)jm * 2048 * 1024, nullptr, scr, r, lane, RM_GLU());
            continue; }
        r -= n_mix;
        if (r < I_UP) { transpose_item(args.in[23] + (size_t)layer * 1024 * 5632, 1024, 5632, (bf16*)(ws + WS_WUP) + (size_t)layer * 5632 * 1024, args.in[8] + (size_t)layer * 1024, scr, r, lane, RM_UP()); continue; }
        r -= I_UP;
        transpose_item(args.in[26] + (size_t)layer * 2816 * 1024, 2816, 1024, (bf16*)(ws + WS_WDN) + (size_t)layer * 1024 * 2816, nullptr, scr, r, lane, RM_RES());
    }
}

#ifndef ONLY_KIND
#define ONLY_KIND -1
#endif
#define EN(k) (ONLY_KIND < 0 || ONLY_KIND == (k))
#ifndef SAMPLE
#define SAMPLE 1
#endif
__global__ void __launch_bounds__(NWAVES * 64, 2) mega_fwd(Args args) {
    extern __shared__ __attribute__((aligned(16))) unsigned char lds[];
    LAS unsigned char* L = (LAS unsigned char*)lds;
    volatile LAS unsigned* MISC = (volatile LAS unsigned*)(L + MISC_OFF);
    const int G = gridDim.x, bx = blockIdx.x; const int vcu = (G % 8 == 0) ? (bx % 8) * (G / 8) + bx / 8 : bx;
    unsigned char* ws = args.ws;
    gu32* ctl = (gu32*)(ws + WS_CTL);
    float* out = args.out; float* x = out;
    bf16* XB = (bf16*)(ws + WS_XB); float* SS = (float*)(ws + WS_SS);
    bf16* Qb = (bf16*)(ws + WS_Q); bf16* Kb = (bf16*)(ws + WS_K); bf16* Vb = (bf16*)(ws + WS_V); bf16* Ob = (bf16*)(ws + WS_O);
    bf16* ACT = (bf16*)(ws + WS_ACT); float* HALO = (float*)(ws + WS_HALO);
    float* SSS = (float*)(ws + sg::WS_SSS); float* QKVS = (float*)(ws + sg::WS_QKVS);
    for (int u = threadIdx.x; u < (LDS_BYTES - LDSCTL_OFF) / 4; u += NWAVES * 64) ((LAS unsigned*)(L + LDSCTL_OFF))[u] = 0u;
    __syncthreads();
    XcdBarrier bar = xcd_barrier_post((unsigned*)(ctl + CW_BAR) + args.li * XCD_BAR_WORDS, MISC + 8);

    for (int ph = args.ph_lo; ph < args.ph_hi; ++ph) {
        int layer, kind; phase_decode(ph, layer, kind);
        const int tid = opaque_tid(), lane = tid & 63, wave = __builtin_amdgcn_readfirstlane(tid >> 6);
        const int jm = layer >> 1;
        const sg::P sp{x + (size_t)MP * 1024, XB + (size_t)MP * 1024, SSS, QKVS, ACT + (size_t)MP * 2816, args.in[24] + (size_t)layer * 3 * 5632, args.in[25] + (size_t)layer * 5632,
                       args.in[6] + (size_t)layer * DB * 2 * 5632, out + O_CS + (size_t)layer * DB * 2 * 5632};
        const int gwv = vcu * NWAVES + wave;
        if (kind == K_PRO && EN(K_PRO)) {
            LAS float* scr = (LAS float*)(L + wave * 16384);
            const int gw = vcu * NWAVES + wave, NGW = G * NWAVES;
            convert_layer(args, ws, 0, gw, NGW, scr, lane);
            if ((gw & 15) == 0 || G != 256) for (int t = (G == 256 ? (gw >> 4) : gw) * 64 + lane; t < 8192; t += (G == 256 ? NGW / 16 : NGW) * 64) { const int j = t >> 12, gp = t & 4095;
                ssm::build_tables(ws, j, gp, args.in[14] + (size_t)j * 4096, args.in[15] + (size_t)j * 4096, args.in[16] + j * 64, args.in[17] + (size_t)j * 65536, args.in[18] + (size_t)j * 65536,
                                  args.in[19] + (size_t)j * 65536, args.in[20] + (size_t)j * 65536, args.in[21] + (size_t)j * 1024, args.in[7] + (size_t)(2 * j + 1) * 1024); }
            for (int m = gw; m + NGW < MP; m += 2 * NGW) x_rows2_init(args.in[0] + (size_t)m * 1024, args.in[0] + (size_t)(m + NGW) * 1024, XB + (size_t)m * 1024, XB + (size_t)(m + NGW) * 1024, SS + (size_t)m * 32, SS + (size_t)(m + NGW) * 32, lane);
            for (int m = gw; m < DB; m += NGW) x_row_init(args.in[1] + (size_t)m * 1024, x + (size_t)(MP + m) * 1024, XB + (size_t)(MP + m) * 1024, SSS + (size_t)m * 64, 64, lane);
        } else if (kind == K_QKV && EN(K_QKV)) {
            if (SAMPLE) for (int u = G - 1 - bx; u < 96; u += G) sg::unit<sg::M_QKV, 1024, 8>(u, XB + (size_t)MP * 1024, (const bf16*)(ws + WS_WQKV) + (size_t)jm * 1536 * 1024, sp, L);
            pg8::Gemm g{XB, (const bf16*)(ws + WS_WQKV) + (size_t)jm * 1536 * 1024, MP, 1536, 1024}; pg8::StaticOrder S; S.init(MP, 1536, G, bx);
            if (tid < 128) ((LAS float*)(L + XL_CV))[tid] = tid < 64 ? args.in[11][jm * 64 + tid] : args.in[12][jm * 64 + tid - 64];
            prestage<false, false>(L, S, SS, 4, nullptr, nullptr);
            pg8::EpiQKV E{Qb, Kb, Vb, (LAS const float*)(L + XL_RS), (LAS const float*)(L + XL_CV), (LAS const float*)(L + XL_CV) + 64, out + O_KP + (size_t)jm * NB * WIN * 256, out + O_VP + (size_t)jm * NB * WIN * 256};
            pg8::gemm_phase<pg8::EpiQKV, pg8::StaticOrder, true, true, false>(L, g, S, E);
            if (G == 256 && bx >= 128) convert_layer(args, ws, layer + 1, (bx - 128) * NWAVES + wave, 128 * NWAVES, (LAS float*)(L + wave * 16384), lane);
        } else if (kind == K_ATT && EN(K_ATT)) {
            if (!(bx & 1)) {
            if (SAMPLE) for (int pid0 = 2 * vcu; pid0 < 512; pid0 += 2 * G) sg::attn_pairs(pid0, QKVS, args.in[2] + (size_t)jm * DB * WIN * 256, args.in[3] + (size_t)jm * DB * WIN * 256, args.in[11] + jm * 64, args.in[12] + jm * 64,
                                                                                   args.in[13] + jm * 16, Ob + (size_t)MP * 1024, out + O_KS + (size_t)jm * DB * WIN * 256, out + O_VS + (size_t)jm * DB * WIN * 256, L);
            }
            { const att::Roll rl{(const f32x4*)(args.in[2] + (size_t)jm * DB * WIN * 256), (const f32x4*)(args.in[3] + (size_t)jm * DB * WIN * 256), (f32x4*)(out + O_KS + (size_t)jm * DB * WIN * 256), (f32x4*)(out + O_VS + (size_t)jm * DB * WIN * 256)};
              { const int id = vcu * 4; if (id < 1024) att::attn_units4(id >> 8, id & 63, (id >> 6) & 3, Qb, Kb, Vb, Ob, args.in[13] + jm * 16, (LAS char*)L, rl, SAMPLE ? id : -1); } }
            if (bx & 1) {
            if (SAMPLE) for (int pid0 = 2 * vcu; pid0 < 512; pid0 += 2 * G) sg::attn_pairs(pid0, QKVS, args.in[2] + (size_t)jm * DB * WIN * 256, args.in[3] + (size_t)jm * DB * WIN * 256, args.in[11] + jm * 64, args.in[12] + jm * 64,
                                                                                   args.in[13] + jm * 16, Ob + (size_t)MP * 1024, out + O_KS + (size_t)jm * DB * WIN * 256, out + O_VS + (size_t)jm * DB * WIN * 256, L);
            }
        } else if (kind == K_WO && EN(K_WO)) {
            if (SAMPLE) for (int u = G - 1 - bx; u < 256; u += G) sg::unit<sg::M_RES, 1024, 2>(u, Ob + (size_t)MP * 1024, (const bf16*)(ws + WS_WO) + (size_t)jm * 1024 * 1024, sp, L);
            pg8::Gemm g{Ob, (const bf16*)(ws + WS_WO) + (size_t)jm * 1024 * 1024, MP, 1024, 1024}; pg8::StaticOrder S; S.init(MP, 1024, G, bx);
            pg8::EpiRes E{nullptr, XB, SS};
            pg8::gemm_phase<pg8::EpiRes, pg8::StaticOrder, true, true, false>(L, g, S, E);
        } else if (kind == K_S1 && EN(K_S1)) {
            if (SAMPLE) for (int pr = gwv; pr < 4096; pr += G * NWAVES) { const int nn[2] = {pr >> 6, (pr + 4096) >> 6}, gg[2] = {pr & 63, pr & 63};
                sg::ssm_step2(nn, gg, ssm::tab_of(ws, jm), x + (size_t)MP * 1024, SSS, args.in[4] + (size_t)jm * DB * 4096, args.in[5] + (size_t)jm * DB * 4096,
                              Ob + (size_t)MP * 1024, out + O_SRS + (size_t)jm * DB * 4096, out + O_SIS + (size_t)jm * DB * 4096, (LAS f32x2*)(L + wave * ssm::WREG), lane); }
            for (int id = vcu; id < 256; id += G) ssm::unit<false>(id >> 6, id & 63, ssm::tab_of(ws, jm), XB, SS, (f32x2*)(ws + WS_SSM + 2 * MiB), Ob, L);
        } else if (kind == K_S2 && EN(K_S2)) {
            ssm::carries(vcu, G, ssm::tab_of(ws, jm), (const f32x2*)(ws + WS_SSM + 2 * MiB), (f32x2*)(ws + WS_SSM + 18 * MiB), out + O_SRP + (size_t)jm * NB * 4096, out + O_SIP + (size_t)jm * NB * 4096);
            if (layer + 1 < DEPTH) convert_layer(args, ws, layer + 1, vcu * NWAVES + wave, G * NWAVES, (LAS float*)(L + wave * 16384), lane);
        } else if (kind == K_S3 && EN(K_S3)) {
            for (int id = vcu; id < 256; id += G) ssm::unit<true>(id >> 6, id & 63, ssm::tab_of(ws, jm), XB, SS, (f32x2*)(ws + WS_SSM + 18 * MiB), Ob, L);
        } else if (kind == K_GLU && EN(K_GLU)) {
            if (SAMPLE) for (int u = G - 1 - bx; u < 256; u += G) sg::unit<sg::M_GLU, 1024, 2>(u, Ob + (size_t)MP * 1024, (const bf16*)(ws + WS_WGLU) + (size_t)jm * 2048 * 1024, sp, L);
            pg8::Gemm g{Ob, (const bf16*)(ws + WS_WGLU) + (size_t)jm * 2048 * 1024, MP, 2048, 1024}; pg8::StaticOrder S; S.init(MP, 2048, G, bx);
            pg8::EpiGlu E{XB, SS};
            pg8::gemm_phase<pg8::EpiGlu, pg8::StaticOrder, true, true, false>(L, g, S, E);
        } else if (kind == K_UP && EN(K_UP)) {
            if (SAMPLE) {
                const bool slack = G == 256;
                for (int k = 0; k < 3; ++k) { const int u = slack ? (bx >= 128 ? (bx - 128) + 128 * k : 352) : (k < 2 ? (G - 1 - bx) + 256 * k : 352);
                    if (u < 352) sg::unit<sg::M_UP, 1024, 4>(u, XB + (size_t)MP * 1024, (const bf16*)(ws + WS_WUP) + (size_t)layer * 5632 * 1024, sp, L); }
            }
            pg8::Gemm g{XB, (const bf16*)(ws + WS_WUP) + (size_t)layer * 5632 * 1024, MP, 5632, 1024}; pg8::StaticOrder S; S.init(MP, 5632, G, bx);
            prestage<true, true>(L, S, SS, (layer & 1) ? 8 : 4, args.in[24] + (size_t)layer * 3 * 5632, args.in[25] + (size_t)layer * 5632);
            pg8::EpiUp E{ACT, HALO, (LAS const float*)(L + XL_RS), (LAS const float*)(L + XL_CV)};
            pg8::gemm_phase<pg8::EpiUp, pg8::StaticOrder, true, true, true>(L, g, S, E);
        } else if (kind == K_DN && EN(K_DN)) {
            pg8::Gemm g{ACT, (const bf16*)(ws + WS_WDN) + (size_t)layer * 1024 * 2816, MP, 1024, 2816}; pg8::StaticOrder S; S.init(MP, 1024, G, bx);
            { pg8::Unit u0; for (int i = 0; S.next(i, u0); ++i) ffn_fixup(u0.pm, u0.pn == 0, HALO, args.in[24] + (size_t)layer * 3 * 5632, args.in[25] + (size_t)layer * 5632, ACT, out + O_CP + (size_t)layer * NB * 2 * 5632); }
            if (SAMPLE) for (int u = G - 1 - bx; u < 256; u += G) sg::unit<sg::M_RES, 2816, 2>(u, ACT + (size_t)MP * 2816, (const bf16*)(ws + WS_WDN) + (size_t)layer * 1024 * 2816, sp, L);
            __builtin_amdgcn_s_waitcnt(0x0F70); VM_WAIT(); __syncthreads();
            __builtin_amdgcn_s_waitcnt(0x0F70);
            pg8::EpiRes E{layer == DEPTH - 1 ? x : nullptr, XB, SS};
            pg8::gemm_phase<pg8::EpiRes, pg8::StaticOrder, true, true, false>(L, g, S, E);
        }
        if (ph + 1 < args.ph_hi) xcd_barrier(bar);
    }
}
extern "C" void kernel_launch(void* const* d_in, const int* in_sizes, int n_in, void* d_out, int out_size, void* d_ws, size_t ws_size, hipStream_t stream) {
    static int grid = 0;
    if (grid == 0) {
        if (n_in != 27 || ws_size < WS_END || (size_t)out_size != O_END) { fprintf(stderr, "kernel_launch: unexpected sizes: n_in %d ws %zu out %d\n", n_in, ws_size, out_size); grid = -1; return; }
        int dev = 0, cus = 0, per_cu = 0;
        if (hipGetDevice(&dev) != hipSuccess || hipDeviceGetAttribute(&cus, hipDeviceAttributeMultiprocessorCount, dev) != hipSuccess) { grid = -1; return; }
        if (hipFuncSetAttribute((const void*)mega_fwd, hipFuncAttributeMaxDynamicSharedMemorySize, LDS_BYTES) != hipSuccess) { fprintf(stderr, "kernel_launch: hipFuncSetAttribute failed\n"); grid = -1; return; }
        if (hipOccupancyMaxActiveBlocksPerMultiprocessor(&per_cu, (const void*)mega_fwd, NWAVES * 64, LDS_BYTES) != hipSuccess || per_cu < 1) { fprintf(stderr, "kernel_launch: occupancy query says %d blocks per CU\n", per_cu); grid = -1; (void)hipGetLastError(); return; }
        (void)hipGetLastError();
        if (cus < 256) { fprintf(stderr, "kernel_launch: %d CUs; this kernel's phase programs are laid out for 256 co-resident workgroups\n", cus); grid = -1; return; }
        grid = 256;
    }
    if (grid < 0) return;
    (void)hipMemsetAsync((unsigned char*)d_ws + WS_CTL, 0, CTL_ZERO_BYTES, stream);
    Args a{}; for (int i = 0; i < 27; ++i) a.in[i] = (const float*)d_in[i];
    a.out = (float*)d_out; a.ws = (unsigned char*)d_ws; a.ph_lo = 0; a.ph_hi = N_PHASES; a.li = 0;
    hipLaunchKernelGGL(mega_fwd, dim3(grid), dim3(NWAVES * 64), LDS_BYTES, stream, a);
}
```

```cpp
#include <hip/hip_runtime.h>
#include <cstdio>
#include <cstdint>
#include <cmath>

constexpr int D = 1024, NB = 4, SEQ = 4096, DEPTH = 4, DB = 128;
constexpr int MP = NB * SEQ;
constexpr int MT = MP + DB;
constexpr int NH = 16, NKV = 4, HD = 64, WIN = 128;
constexpr int NQKV = (NH + 2 * NKV) * HD;
constexpr int NG = 64, SG = 16, NS = 64;
constexpr int FF = 2816, F2 = 2 * FF;
constexpr float EPS = 1e-6f;

constexpr size_t O_Y = 0;
constexpr size_t O_YS = O_Y + (size_t)MP * D;
constexpr size_t O_KP = O_YS + (size_t)DB * D;
constexpr size_t O_VP = O_KP + (size_t)2 * NB * WIN * NKV * HD;
constexpr size_t O_KS = O_VP + (size_t)2 * NB * WIN * NKV * HD;
constexpr size_t O_VS = O_KS + (size_t)2 * DB * WIN * NKV * HD;
constexpr size_t O_SRP = O_VS + (size_t)2 * DB * WIN * NKV * HD;
constexpr size_t O_SIP = O_SRP + (size_t)2 * NB * NG * NS;
constexpr size_t O_SRS = O_SIP + (size_t)2 * NB * NG * NS;
constexpr size_t O_SIS = O_SRS + (size_t)2 * DB * NG * NS;
constexpr size_t O_CP = O_SIS + (size_t)2 * DB * NG * NS;
constexpr size_t O_CS = O_CP + (size_t)DEPTH * NB * 2 * F2;
constexpr size_t O_END = O_CS + (size_t)DEPTH * DB * 2 * F2;

#define GAS __attribute__((address_space(1)))
#define LAS __attribute__((address_space(3)))
typedef unsigned short bf16;
typedef unsigned v4u __attribute__((ext_vector_type(4)));
typedef unsigned v2u __attribute__((ext_vector_type(2)));
typedef float f32x4 __attribute__((ext_vector_type(4)));
typedef float f32x2 __attribute__((ext_vector_type(2)));
typedef short bf16x8 __attribute__((ext_vector_type(8)));
typedef GAS unsigned gu32;
#define RLX_AGENT __ATOMIC_RELAXED, __HIP_MEMORY_SCOPE_AGENT
#define LDS_WAIT() asm volatile("s_waitcnt lgkmcnt(0)" ::: "memory")
#define VM_WAIT() asm volatile("s_waitcnt vmcnt(0)" ::: "memory")
__device__ __forceinline__ unsigned pk2(float lo, float hi) { unsigned r; asm("v_cvt_pk_bf16_f32 %0, %1, %2" : "=v"(r) : "v"(lo), "v"(hi)); return r; }
__device__ __forceinline__ unsigned f2bf(float f) { return pk2(f, 0.f) & 0xffffu; }
__device__ __forceinline__ unsigned pk2q(float lo, float hi) { return __builtin_amdgcn_perm(__builtin_bit_cast(unsigned, hi) + 0x8000u, __builtin_bit_cast(unsigned, lo) + 0x8000u, 0x07060302u); }
__device__ __forceinline__ float bf2f(unsigned short b) { return __builtin_bit_cast(float, (unsigned)b << 16); }
__device__ __forceinline__ float dpp_shr1(float v) { return __builtin_bit_cast(float, __builtin_amdgcn_update_dpp(0, __builtin_bit_cast(int, v), 0x111, 0xf, 0xf, true)); }

__device__ __forceinline__ int opaque_tid() { int t = threadIdx.x; asm volatile("" : "+v"(t)); return t; }

__device__ __forceinline__ float wave_sum(float v) {
#pragma unroll
    for (int o = 1; o < 64; o <<= 1) v += __shfl_xor(v, o);
    return v;
}

constexpr float LOG2E = 1.4426950408889634f;
constexpr float QSCALE = 0.125f * LOG2E;

constexpr size_t MiB = 1u << 20;
constexpr size_t WS_CTL = 0, CTL_ZERO_BYTES = 1 * MiB;
constexpr size_t WS_WQKV = 1 * MiB;
constexpr size_t WS_WO = 7 * MiB;
constexpr size_t WS_WGLU = 11 * MiB;
constexpr size_t WS_WUP = 19 * MiB;
constexpr size_t WS_WDN = 63 * MiB;
constexpr size_t WS_XB = 85 * MiB;
constexpr size_t WS_SS = 118 * MiB;
constexpr size_t WS_Q = 121 * MiB;
constexpr size_t WS_K = 154 * MiB;
constexpr size_t WS_V = 163 * MiB;
constexpr size_t WS_O = 172 * MiB;
constexpr size_t WS_ACT = 205 * MiB;
constexpr size_t WS_HALO = 294 * MiB;
constexpr size_t WS_SSM = 316 * MiB;
constexpr size_t WS_END = 352 * MiB;

constexpr int CW_BAR = 4096;
namespace pg8 {
#define PG8_LAS __attribute__((address_space(3)))
typedef unsigned short bf16_t;
typedef short bf16x8 __attribute__((ext_vector_type(8)));
typedef float f32x4 __attribute__((ext_vector_type(4)));
typedef unsigned u32x4 __attribute__((ext_vector_type(4)));
constexpr int BM = 256, BK = 64, HALF = 128, HTB = HALF * BK * 2  , STAGE_BYTES = 8 * HTB, NXCD = 8, WGM = 8;

__host__ __device__ __forceinline__ int lds_byte(int r, int c) { const int st = (r >> 4) * 2 + (c >> 5), rr = r & 15, cc = c & 31, ob = rr * 64 + cc * 2; return st * 1024 + (ob ^ (((ob >> 9) & 1) << 5)); }
__host__ __device__ __forceinline__ void stage_rc(int b, int& R, int& C) { const int st = b / 1024, sb = b % 1024, swz = sb ^ (((sb >> 9) & 1) << 5); R = (st >> 1) * 16 + swz / 64; C = (st & 1) * 32 + (swz % 64) / 2; }
__host__ __device__ __forceinline__ int perm32(int rho) { const int n = rho >> 4, i = rho & 15; return 8 * (i >> 2) + 4 * n + (i & 3); }

struct Unit { int pm, pn; };
struct Gemm { const bf16_t* A; const bf16_t* Bt; int M, N, K; };

struct StaticOrder {
    int nM, nN, nwg, G, c;
    __host__ __device__ void init(int M, int N, int G_, int c_) { nM = M / BM; nN = N / BM; nwg = nM * nN; G = G_; c = c_; }
    __host__ __device__ bool next(int i, Unit& u) const {
        const long L = (long)i * G + c; if (L >= nwg) return false;
        int wgid = (int)L; { const int q = nwg / NXCD, r = nwg % NXCD, xcd = wgid % NXCD, off = wgid / NXCD; wgid = (xcd < r ? xcd * (q + 1) : r * (q + 1) + (xcd - r) * q) + off; }
        const int nig = WGM * nN, gid = wgid / nig, fm = gid * WGM, gsz = (nM - fm) < WGM ? (nM - fm) : WGM;
        u.pm = fm + ((wgid % nig) % gsz); u.pn = (wgid % nig) / gsz; return true;
    }
    __device__ __forceinline__ void a_ready(const Unit&) const {}
    __device__ __forceinline__ void done(const Unit&) const {}
};

__device__ __forceinline__ unsigned cvt_pk_bf16(float lo, float hi) { unsigned r; asm volatile("v_cvt_pk_bf16_f32 %0, %1, %2" : "=v"(r) : "v"(lo), "v"(hi)); return r; }
typedef unsigned u32x2 __attribute__((ext_vector_type(2)));
__device__ __forceinline__ void st_b32(void* p, float v) { asm volatile("global_store_dword %0, %1, off" :: "v"(p), "v"(v) : "memory"); }
__device__ __forceinline__ void st_b64(void* p, u32x2 v) { asm volatile("global_store_dwordx2 %0, %1, off" :: "v"(p), "v"(v) : "memory"); }
__device__ __forceinline__ void st_b128(void* p, u32x4 v) { asm volatile("global_store_dwordx4 %0, %1, off\n\ts_nop 1" :: "v"(p), "v"(v) : "memory"); }
__device__ __forceinline__ void st_f128(void* p, f32x4 v) { asm volatile("global_store_dwordx4 %0, %1, off\n\ts_nop 1" :: "v"(p), "v"(v) : "memory"); }

template <bool APERM>
__device__ __forceinline__ void row_scales(const float* __restrict__ ss, int np4  , int rowbase  , int lane, int fr, float (&rs)[2][4]) {
    const int mm = lane >> 4, ff = lane & 15, rloc = APERM ? (4 * ff + mm) : (16 * mm + ff);
    float v[2];
#pragma unroll
    for (int ai = 0; ai < 2; ++ai) {
        const f32x4* p = (const f32x4*)(ss + (size_t)(rowbase + 128 * ai + rloc) * 32);
        float s = 0.f;
        for (int i = 0; i < np4; ++i) { const f32x4 t = p[i]; s += (t[0] + t[1]) + (t[2] + t[3]); }
        v[ai] = __builtin_amdgcn_rsqf(s * (1.0f / 1024.0f) + 1e-6f);
    }
#pragma unroll
    for (int ai = 0; ai < 2; ++ai)
#pragma unroll
        for (int m = 0; m < 4; ++m) rs[ai][m] = __shfl(v[ai], 16 * m + fr);
}

struct EpiQKV {
    bf16_t* Q; bf16_t* Kb; bf16_t* Vb; PG8_LAS const float* rsl; PG8_LAS const float* qg; PG8_LAS const float* kg; float* kout; float* vout;
    __device__ __forceinline__ void operator()(const f32x4 (&acc)[2][2][4][2], const Unit& u, int ui, int wr, int wc, int fr, int fq) const {
        const int rowbase = u.pm * BM + wr * 64;
        float rs[2][4];
#pragma unroll
        for (int ai = 0; ai < 2; ++ai)
#pragma unroll
            for (int m = 0; m < 4; ++m) rs[ai][m] = rsl[ui * 256 + 128 * ai + 64 * wr + 16 * m + fr];
        const int kind = u.pn < 4 ? 0 : (u.pn == 4 ? 1 : 2);
        f32x4 gn[2][2];
#pragma unroll
        for (int bj = 0; bj < 2; ++bj)
#pragma unroll
            for (int n = 0; n < 2; ++n) gn[bj][n] = kind == 2 ? (f32x4){1.f, 1.f, 1.f, 1.f} : *(const PG8_LAS f32x4*)((kind == 0 ? qg : kg) + 32 * bj + 8 * fq + 4 * n);
        bf16_t* dst = kind == 0 ? Q + (size_t)(4 * u.pn + wc) * 64 : (kind == 1 ? Kb : Vb) + (size_t)wc * 64;
        const int pitch = kind == 0 ? 1024 : 256;
        const bool tail = (kind != 0) && ((u.pm & 15) == 15);
        float* fo = kind == 1 ? kout : vout;
#pragma unroll
        for (int ai = 0; ai < 2; ++ai)
#pragma unroll
            for (int m = 0; m < 4; ++m) {
                const int row = rowbase + 128 * ai + 16 * m + fr; const float r = rs[ai][m];
                f32x4 v[2][2]; float s = 0.f;
#pragma unroll
                for (int bj = 0; bj < 2; ++bj)
#pragma unroll
                    for (int n = 0; n < 2; ++n) { v[bj][n] = acc[ai][bj][m][n] * r; const f32x4 t = v[bj][n]; s += (t[0] * t[0] + t[1] * t[1]) + (t[2] * t[2] + t[3] * t[3]); }
                if (kind != 2) {
                    s += __shfl_xor(s, 16); s += __shfl_xor(s, 32);
                    const float hr = (__builtin_amdgcn_rsqf(s * (1.0f / 64.0f) + 1e-6f)) * (kind == 0 ? QSCALE : 1.0f);
#pragma unroll
                    for (int bj = 0; bj < 2; ++bj)
#pragma unroll
                        for (int n = 0; n < 2; ++n) v[bj][n] = v[bj][n] * hr * gn[bj][n];
                }
#pragma unroll
                for (int bj = 0; bj < 2; ++bj) {
                    u32x4 w; w.x = cvt_pk_bf16(v[bj][0][0], v[bj][0][1]); w.y = cvt_pk_bf16(v[bj][0][2], v[bj][0][3]); w.z = cvt_pk_bf16(v[bj][1][0], v[bj][1][1]); w.w = cvt_pk_bf16(v[bj][1][2], v[bj][1][3]);
                    st_b128(dst + (size_t)row * pitch + 32 * bj + 8 * fq, w);
                }
                if (tail && ai == 1) {
                    const int nb = u.pm >> 4, w = 16 * m + fr + 64 * wr;
                    float* o = fo + ((size_t)(nb * 128 + w)) * 256 + wc * 64 + 8 * fq;
#pragma unroll
                    for (int bj = 0; bj < 2; ++bj) { st_f128(o + 32 * bj, v[bj][0]); st_f128(o + 32 * bj + 4, v[bj][1]); }
                }
            }
    }
};

struct EpiRes {
    float* xout; bf16_t* xb; float* ss;
    __device__ __forceinline__ void operator()(const f32x4 (&acc)[2][2][4][2], const Unit& u, int ui, int wr, int wc, int fr, int fq) const {
        const int rowbase = u.pm * BM + wr * 64, col0 = u.pn * BM + wc * 32 + 8 * fq;
#pragma unroll
        for (int ai = 0; ai < 2; ++ai)
#pragma unroll
            for (int m = 0; m < 4; ++m) {
                const int row = rowbase + 128 * ai + 16 * m + fr; float s = 0.f;
                bf16_t* br = xb + (size_t)row * 1024 + col0;
                u32x4 xin[2];
#pragma unroll
                for (int bj = 0; bj < 2; ++bj) xin[bj] = *(const u32x4*)(br + bj * HALF);
                f32x2 s2 = {0.f, 0.f};
#pragma unroll
                for (int bj = 0; bj < 2; ++bj) {
                    const u32x4 xw = xin[bj];
                    f32x2 p[4]; u32x4 w;
#pragma unroll
                    for (int c = 0; c < 4; ++c) {
                        const unsigned xc = c == 0 ? xw.x : c == 1 ? xw.y : c == 2 ? xw.z : xw.w;
                        const f32x4 a4 = acc[ai][bj][m][c >> 1];
                        const f32x2 xv = {__builtin_bit_cast(float, xc << 16), __builtin_bit_cast(float, xc & 0xffff0000u)};
                        p[c] = (f32x2){a4[2 * (c & 1)], a4[2 * (c & 1) + 1]} + xv;
                        s2 = __builtin_elementwise_fma(p[c], p[c], s2);
                    }
                    w.x = cvt_pk_bf16(p[0].x, p[0].y); w.y = cvt_pk_bf16(p[1].x, p[1].y); w.z = cvt_pk_bf16(p[2].x, p[2].y); w.w = cvt_pk_bf16(p[3].x, p[3].y);
                    st_b128(br + bj * HALF, w);
                    if (xout) { float* xo = xout + (size_t)row * 1024 + col0 + bj * HALF; st_f128(xo, (f32x4){p[0].x, p[0].y, p[1].x, p[1].y}); st_f128(xo + 4, (f32x4){p[2].x, p[2].y, p[3].x, p[3].y}); }
                }
                s = s2.x + s2.y;
                s += __shfl_xor(s, 16); s += __shfl_xor(s, 32);
                if (fq == 0) st_b32(ss + (size_t)row * 32 + 4 * u.pn + wc, s);
                if (m & 1) asm volatile("" ::: "memory");
            }
    }
};

struct EpiGlu {
    bf16_t* xb; float* ss;
    __device__ __forceinline__ void operator()(const f32x4 (&acc)[2][2][4][2], const Unit& u, int ui, int wr, int wc, int fr, int fq) const {
        const int rowbase = u.pm * BM + wr * 64, col0 = u.pn * 128 + wc * 32 + 8 * fq;
#pragma unroll
        for (int ai = 0; ai < 2; ++ai)
#pragma unroll
            for (int m = 0; m < 4; ++m) {
                const int row = rowbase + 128 * ai + 16 * m + fr; float s = 0.f;
                bf16_t* br = xb + (size_t)row * 1024 + col0;
                const u32x4 xw = *(const u32x4*)br;
                f32x2 s2 = {0.f, 0.f}; u32x4 w;
#pragma unroll
                for (int c = 0; c < 4; ++c) {
                    const unsigned xc = c == 0 ? xw.x : c == 1 ? xw.y : c == 2 ? xw.z : xw.w;
                    const f32x4 a4 = acc[ai][0][m][c >> 1], b4 = acc[ai][1][m][c >> 1];
                    const f32x2 a2 = {a4[2 * (c & 1)], a4[2 * (c & 1) + 1]}, b2 = {b4[2 * (c & 1)], b4[2 * (c & 1) + 1]};
                    const f32x2 t2 = b2 * (f32x2){-LOG2E, -LOG2E};
                    const f32x2 d2 = (f32x2){__builtin_amdgcn_exp2f(t2.x), __builtin_amdgcn_exp2f(t2.y)} + (f32x2){1.0f, 1.0f};
                    const f32x2 r2 = {__builtin_amdgcn_rcpf(d2.x), __builtin_amdgcn_rcpf(d2.y)};
                    const f32x2 xv = {__builtin_bit_cast(float, xc << 16), __builtin_bit_cast(float, xc & 0xffff0000u)};
                    const f32x2 o2 = __builtin_elementwise_fma(a2, r2, xv);
                    s2 = __builtin_elementwise_fma(o2, o2, s2);
                    const unsigned wc_ = cvt_pk_bf16(o2.x, o2.y);
                    if (c == 0) w.x = wc_; else if (c == 1) w.y = wc_; else if (c == 2) w.z = wc_; else w.w = wc_;
                }
                s = s2.x + s2.y;
                st_b128(br, w);
                s += __shfl_xor(s, 16); s += __shfl_xor(s, 32);
                if (fq == 0) st_b32(ss + (size_t)row * 32 + 4 * u.pn + wc, s);
            }
    }
};

__device__ __forceinline__ f32x2 gate2(f32x2 g2, f32x2 ug, f32x2 gb, f32x2 g1, f32x2 a1, f32x2 g0, f32x2 a2, f32x2 h2, f32x2 uv, f32x2 hb, f32x2 h1, f32x2 b1, f32x2 h0, f32x2 b2, f32x2 nl2e, f32x2 one2) {
    f32x2 cg = __builtin_elementwise_fma(g2, ug, gb), cv = __builtin_elementwise_fma(h2, uv, hb);
    cg = __builtin_elementwise_fma(g1, a1, cg); cv = __builtin_elementwise_fma(h1, b1, cv);
    cg = __builtin_elementwise_fma(g0, a2, cg); cv = __builtin_elementwise_fma(h0, b2, cv);
    const f32x2 d = (f32x2){__builtin_amdgcn_exp2f(cg.x), __builtin_amdgcn_exp2f(cg.y)} + one2;
    const f32x2 r = {__builtin_amdgcn_rcpf(d.x), __builtin_amdgcn_rcpf(d.y)};
    return (cg * cv) * r;
}
#define PG8_LO2(v) __builtin_shufflevector(v, v, 0, 1)
#define PG8_HI2(v) __builtin_shufflevector(v, v, 2, 3)
struct EpiUp {
    bf16_t* act; float* halo; PG8_LAS const float* rsl; PG8_LAS const float* cvl;
    __device__ __forceinline__ void operator()(const f32x4 (&acc)[2][2][4][2], const Unit& u, int ui, int wr, int wc, int fr, int fq) const {
        const int rowbase = u.pm * BM + wr * 128, j0 = u.pn * 128 + wc * 32 + 8 * fq, blk = 2 * u.pm + wr;
        float rs[2][4];
#pragma unroll
        for (int ai = 0; ai < 2; ++ai) { const f32x4 t = *(const PG8_LAS f32x4*)(rsl + ui * 256 + 128 * wr + 8 * fr + 4 * ai); rs[ai][0] = t[0]; rs[ai][1] = t[1]; rs[ai][2] = t[2]; rs[ai][3] = t[3]; }
        const PG8_LAS float* cv0 = cvl + ui * 1024 + wc * 32 + 8 * fq;
        const f32x2 nl2e = {-LOG2E, -LOG2E}, one2 = {1.0f, 1.0f};
        u32x4 outw[2][4];
#pragma unroll
        for (int n = 0; n < 2; ++n) {
            const int j = j0 + 4 * n;
            const PG8_LAS float* cvn = cv0 + 4 * n;
            const f32x4 g0 = *(const PG8_LAS f32x4*)(cvn), g1 = *(const PG8_LAS f32x4*)(cvn + 128), g2 = *(const PG8_LAS f32x4*)(cvn + 256), gb = *(const PG8_LAS f32x4*)(cvn + 384);
            const f32x4 h0 = *(const PG8_LAS f32x4*)(cvn + 512), h1 = *(const PG8_LAS f32x4*)(cvn + 640), h2 = *(const PG8_LAS f32x4*)(cvn + 768), hb = *(const PG8_LAS f32x4*)(cvn + 896);
            f32x4 ug[2][4], uv[2][4];
#pragma unroll
            for (int ai = 0; ai < 2; ++ai)
#pragma unroll
                for (int m = 0; m < 4; ++m) { ug[ai][m] = acc[ai][0][m][n] * rs[ai][m]; uv[ai][m] = acc[ai][1][m][n] * rs[ai][m]; }
            if (fr == 0) {
#pragma unroll
                for (int m = 0; m < 2; ++m) { float* hp = halo + ((size_t)blk * 4 + m) * 5632 + j; st_f128(hp, ug[0][m]); st_f128(hp + 2816, uv[0][m]); }
            }
            if (fr == 15) {
#pragma unroll
                for (int m = 2; m < 4; ++m) { float* hp = halo + ((size_t)blk * 4 + m) * 5632 + j; st_f128(hp, ug[1][m]); st_f128(hp + 2816, uv[1][m]); }
            }
            f32x4 pg1, pg2, pv1, pv2;
#pragma unroll
            for (int e = 0; e < 4; ++e) { pg1[e] = dpp_shr1(ug[1][3][e]); pg2[e] = dpp_shr1(ug[1][2][e]); pv1[e] = dpp_shr1(uv[1][3][e]); pv2[e] = dpp_shr1(uv[1][2][e]); }
#pragma unroll
            for (int ai = 0; ai < 2; ++ai)
#pragma unroll
                for (int m = 0; m < 4; ++m) {
                    const f32x4 a1 = ai == 0 ? (m == 0 ? pg1 : ug[0][m > 0 ? m - 1 : 0]) : (m == 0 ? ug[0][3] : ug[1][m > 0 ? m - 1 : 0]);
                    const f32x4 a2 = ai == 0 ? (m == 0 ? pg2 : (m == 1 ? pg1 : ug[0][m > 1 ? m - 2 : 0])) : (m == 0 ? ug[0][2] : (m == 1 ? ug[0][3] : ug[1][m > 1 ? m - 2 : 0]));
                    const f32x4 b1 = ai == 0 ? (m == 0 ? pv1 : uv[0][m > 0 ? m - 1 : 0]) : (m == 0 ? uv[0][3] : uv[1][m > 0 ? m - 1 : 0]);
                    const f32x4 b2 = ai == 0 ? (m == 0 ? pv2 : (m == 1 ? pv1 : uv[0][m > 1 ? m - 2 : 0])) : (m == 0 ? uv[0][2] : (m == 1 ? uv[0][3] : uv[1][m > 1 ? m - 2 : 0]));
                    const f32x2 olo = gate2(PG8_LO2(g2), PG8_LO2(ug[ai][m]), PG8_LO2(gb), PG8_LO2(g1), PG8_LO2(a1), PG8_LO2(g0), PG8_LO2(a2), PG8_LO2(h2), PG8_LO2(uv[ai][m]), PG8_LO2(hb), PG8_LO2(h1), PG8_LO2(b1), PG8_LO2(h0), PG8_LO2(b2), nl2e, one2);
                    const f32x2 ohi = gate2(PG8_HI2(g2), PG8_HI2(ug[ai][m]), PG8_HI2(gb), PG8_HI2(g1), PG8_HI2(a1), PG8_HI2(g0), PG8_HI2(a2), PG8_HI2(h2), PG8_HI2(uv[ai][m]), PG8_HI2(hb), PG8_HI2(h1), PG8_HI2(b1), PG8_HI2(h0), PG8_HI2(b2), nl2e, one2);
                    if (n == 0) { outw[ai][m].x = cvt_pk_bf16(olo.x, olo.y); outw[ai][m].y = cvt_pk_bf16(ohi.x, ohi.y); } else { outw[ai][m].z = cvt_pk_bf16(olo.x, olo.y); outw[ai][m].w = cvt_pk_bf16(ohi.x, ohi.y); }
                }
        }
#pragma unroll
        for (int ai = 0; ai < 2; ++ai)
#pragma unroll
            for (int m = 0; m < 4; ++m) { const int row = rowbase + 8 * fr + 4 * ai + m;
                if (!(fr == 0 && ai == 0 && m < 2)) st_b128(act + (size_t)row * 2816 + j0, outw[ai][m]); }
        asm volatile("" ::: "memory");
    }
};
template <class Epi, class Sched, bool ALIGN_EPI = false, bool SP2 = false, bool APERM = false>
__device__ __forceinline__ void gemm_phase(PG8_LAS unsigned char* lds, const Gemm g, const Sched& S, const Epi& E) {
    const int tid = opaque_tid(), wid = __builtin_amdgcn_readfirstlane(tid >> 6), lane = tid & 63, wr = wid >> 2, wc = wid & 3, fr = lane & 15, fq = lane >> 4;
    const int K = g.K, nt = K / BK;
    unsigned voffA[2], voffB[2];
#pragma unroll
    for (int i = 0; i < 2; ++i) { int R, C; stage_rc(tid * 16 + i * 8192, R, C); const int Ra = APERM ? (((R & 64) << 1) | ((R & 15) << 3) | ((R >> 4) & 3)) : R;
        voffA[i] = (unsigned)(Ra * K + C) * 2u; voffB[i] = (unsigned)(R * K + C) * 2u; }
    const size_t kstep = (size_t)(BK * 2);
    const size_t hstep = (size_t)HALF * K * 2;
    const size_t hstepA = APERM ? (size_t)4 * K * 2 : hstep;
    const size_t tstep = 2 * hstep;
    const unsigned ldsw = (unsigned)wid * 1024u;
    const int aoff = lds_byte(wr * 64 + fr, fq * 8), boff = lds_byte(wc * 32 + fr, fq * 8);
#define PG8_SA(b, h) (((b) * 2 + (h)) * HTB)
#define PG8_SB(b, h) ((4 + (b) * 2 + (h)) * HTB)
#define PG8_STAGE(bufoff, gbase, voff) do { _Pragma("unroll") for (int _i = 0; _i < 2; ++_i) \
        __builtin_amdgcn_global_load_lds((const unsigned*)((const char*)(gbase) + (voff)[_i]), (PG8_LAS unsigned*)(lds + (bufoff) + ldsw + _i * 8192), 16, 0, 0); } while (0)
#define PG8_LDA(dst, b, h) do { _Pragma("unroll") for (int m = 0; m < 4; ++m) _Pragma("unroll") for (int k = 0; k < 2; ++k) dst[m][k] = *(const PG8_LAS bf16x8*)(lds + PG8_SA(b, h) + aoff + m * 2048 + k * 1024); } while (0)
#define PG8_LDB(dst, b, h) do { _Pragma("unroll") for (int n = 0; n < 2; ++n) _Pragma("unroll") for (int k = 0; k < 2; ++k) dst[n][k] = *(const PG8_LAS bf16x8*)(lds + PG8_SB(b, h) + boff + n * 2048 + k * 1024); } while (0)
#define PG8_MMA(ai, bj, At, Bt) do { __builtin_amdgcn_s_setprio(1); _Pragma("unroll") for (int m = 0; m < 4; ++m) _Pragma("unroll") for (int n = 0; n < 2; ++n) _Pragma("unroll") for (int k = 0; k < 2; ++k) \
        acc[ai][bj][m][n] = __builtin_amdgcn_mfma_f32_16x16x32_bf16(Bt[n][k], At[m][k], acc[ai][bj][m][n], 0, 0, 0); __builtin_amdgcn_s_setprio(0); } while (0)
#define PG8_WAIT_V(n) asm volatile("s_waitcnt vmcnt(" #n ")" ::: "memory")
#define PG8_WAIT_L(n) asm volatile("s_waitcnt lgkmcnt(" #n ")" ::: "memory")
#define PG8_BAR __builtin_amdgcn_s_barrier()
#define PG8_SCHED __builtin_amdgcn_sched_barrier(0)
    Unit cur, nxt; int ui = 0;
    if (!S.next(0, cur)) return;
    f32x4 acc[2][2][4][2];
#pragma unroll
    for (int a = 0; a < 2; ++a)
#pragma unroll
        for (int b = 0; b < 2; ++b)
#pragma unroll
            for (int m = 0; m < 4; ++m)
#pragma unroll
                for (int n = 0; n < 2; ++n) acc[a][b][m][n] = (f32x4){0.f, 0.f, 0.f, 0.f};
    bf16x8 At[4][2], B0[2][2], B1[2][2];
    const char* cA = (const char*)g.A + (size_t)cur.pm * tstep; const char* cB = (const char*)g.Bt + (size_t)cur.pn * tstep;
    S.a_ready(cur);
    if constexpr (SP2) {
        PG8_STAGE(PG8_SB(0, 0), cB, voffB); PG8_STAGE(PG8_SB(0, 1), cB + hstep, voffB); PG8_STAGE(PG8_SA(0, 0), cA, voffA); PG8_STAGE(PG8_SA(0, 1), cA + hstepA, voffA);
        if (wr == 1) PG8_BAR;
        PG8_WAIT_V(2); PG8_BAR;
        PG8_STAGE(PG8_SB(1, 0), cB + kstep, voffB); PG8_STAGE(PG8_SA(1, 0), cA + kstep, voffA); PG8_STAGE(PG8_SB(1, 1), cB + hstep + kstep, voffB);
        PG8_WAIT_V(6); PG8_BAR;
    } else {
        PG8_STAGE(PG8_SB(0, 0), cB, voffB); PG8_STAGE(PG8_SA(0, 0), cA, voffA); PG8_STAGE(PG8_SB(0, 1), cB + hstep, voffB); PG8_STAGE(PG8_SA(0, 1), cA + hstepA, voffA);
        if (wr == 1) PG8_BAR;
        PG8_WAIT_V(4); PG8_BAR;
        PG8_STAGE(PG8_SB(1, 0), cB + kstep, voffB); PG8_STAGE(PG8_SA(1, 0), cA + kstep, voffA); PG8_STAGE(PG8_SB(1, 1), cB + hstep + kstep, voffB);
        PG8_WAIT_V(6); PG8_BAR;
    }
    for (;;) {
        const bool has_next = S.next(ui + 1, nxt);
        const char* nA = has_next ? (const char*)g.A + (size_t)nxt.pm * tstep : cA; const char* nB = has_next ? (const char*)g.Bt + (size_t)nxt.pn * tstep : cB;
        for (int t = 0; t < nt; t += 2) {
            const bool last = (t == nt - 2);
            const char* a1 = cA + (size_t)(t + 1) * kstep;
            const char* a2 = last ? nA : cA + (size_t)(t + 2) * kstep; const char* b2 = last ? nB : cB + (size_t)(t + 2) * kstep;
            const char* a3 = a2 + kstep; const char* b3 = b2 + kstep;
            if (last && has_next) S.a_ready(nxt);
            if constexpr (SP2) {
            PG8_LDB(B0, 0, 0); PG8_LDB(B1, 0, 1); PG8_SCHED; PG8_LDA(At, 0, 0); PG8_STAGE(PG8_SA(1, 1), a1 + hstepA, voffA);
            PG8_WAIT_V(8); PG8_WAIT_L(0); PG8_BAR; PG8_MMA(0, 0, At, B0); PG8_MMA(0, 1, At, B1); PG8_BAR; PG8_SCHED;
            PG8_LDA(At, 0, 1); PG8_STAGE(PG8_SB(0, 0), b2, voffB); PG8_STAGE(PG8_SB(0, 1), b2 + hstep, voffB); PG8_STAGE(PG8_SA(0, 0), a2, voffA);
            PG8_WAIT_V(8); PG8_WAIT_L(0); PG8_BAR; PG8_MMA(1, 0, At, B0); PG8_MMA(1, 1, At, B1); PG8_BAR; PG8_SCHED;
            PG8_LDB(B0, 1, 0); PG8_LDB(B1, 1, 1); PG8_SCHED; PG8_LDA(At, 1, 0); PG8_STAGE(PG8_SA(0, 1), a2 + hstepA, voffA);
            PG8_WAIT_V(8); PG8_WAIT_L(0); PG8_BAR; PG8_MMA(0, 0, At, B0); PG8_MMA(0, 1, At, B1); PG8_BAR; PG8_SCHED;
            PG8_LDA(At, 1, 1); PG8_STAGE(PG8_SB(1, 0), b3, voffB); PG8_STAGE(PG8_SB(1, 1), b3 + hstep, voffB); PG8_STAGE(PG8_SA(1, 0), a3, voffA);
            PG8_WAIT_V(8); PG8_WAIT_L(0); PG8_BAR; PG8_MMA(1, 0, At, B0); PG8_MMA(1, 1, At, B1); PG8_BAR; PG8_SCHED;
            } else {
            PG8_LDB(B0, 0, 0); PG8_SCHED; PG8_LDA(At, 0, 0); PG8_STAGE(PG8_SA(1, 1), a1 + hstepA, voffA);
            PG8_WAIT_L(8); PG8_BAR; PG8_WAIT_L(0); PG8_MMA(0, 0, At, B0); PG8_BAR; PG8_SCHED;
            PG8_LDB(B1, 0, 1); PG8_STAGE(PG8_SB(0, 0), b2, voffB);
            PG8_BAR; PG8_WAIT_L(0); PG8_MMA(0, 1, At, B1); PG8_BAR;
            PG8_LDA(At, 0, 1); PG8_STAGE(PG8_SA(0, 0), a2, voffA);
            PG8_BAR; PG8_WAIT_L(0); PG8_MMA(1, 0, At, B0); PG8_BAR; PG8_SCHED;
            PG8_STAGE(PG8_SB(0, 1), b2 + hstep, voffB);
            PG8_WAIT_V(6); PG8_BAR; PG8_MMA(1, 1, At, B1); PG8_BAR;
            PG8_LDB(B0, 1, 0); PG8_SCHED; PG8_LDA(At, 1, 0); PG8_STAGE(PG8_SA(0, 1), a2 + hstepA, voffA);
            PG8_WAIT_L(8); PG8_BAR; PG8_WAIT_L(0); PG8_MMA(0, 0, At, B0); PG8_BAR; PG8_SCHED;
            PG8_LDB(B1, 1, 1); PG8_STAGE(PG8_SB(1, 0), b3, voffB);
            PG8_BAR; PG8_WAIT_L(0); PG8_MMA(0, 1, At, B1); PG8_BAR;
            PG8_LDA(At, 1, 1); PG8_STAGE(PG8_SA(1, 0), a3, voffA);
            PG8_BAR; PG8_WAIT_L(0); PG8_MMA(1, 0, At, B0); PG8_BAR; PG8_SCHED;
            PG8_STAGE(PG8_SB(1, 1), b3 + hstep, voffB);
            PG8_WAIT_V(6); PG8_BAR; PG8_MMA(1, 1, At, B1); PG8_BAR;
            }
        }
        if constexpr (ALIGN_EPI) { if (wr == 0) PG8_BAR; }
        {
            E(acc, cur, ui, wr, wc, fr, fq); S.done(cur);
        }
        if (!has_next) break;
#pragma unroll
        for (int a = 0; a < 2; ++a)
#pragma unroll
            for (int b = 0; b < 2; ++b)
#pragma unroll
                for (int m = 0; m < 4; ++m)
#pragma unroll
                    for (int n = 0; n < 2; ++n) acc[a][b][m][n] = (f32x4){0.f, 0.f, 0.f, 0.f};
        cur = nxt; cA = nA; cB = nB; ++ui;
        if constexpr (ALIGN_EPI) { if (wr == 1) PG8_BAR; }
    }
    PG8_WAIT_V(0);
    if constexpr (!ALIGN_EPI) { if (wr == 0) PG8_BAR; }
    PG8_BAR;
#undef PG8_SA
#undef PG8_SB
#undef PG8_STAGE
#undef PG8_LDA
#undef PG8_LDB
#undef PG8_MMA
#undef PG8_WAIT_V
#undef PG8_WAIT_L
#undef PG8_BAR
#undef PG8_SCHED
}
}


namespace att {
using s16x4 = __attribute__((ext_vector_type(4))) short;
using f32x16 = __attribute__((ext_vector_type(16))) float;
using u32x4 = __attribute__((ext_vector_type(4))) unsigned;
typedef LAS const char* lds_cptr;
constexpr int SLOTB = 8192, LDS_K = 0, LDS_V = 4 * SLOTB, LDS_WS = 8 * SLOTB, LDS_OST = LDS_WS + 8 * 256, LDS_BYTES = LDS_OST + 8 * 4096;
__device__ __forceinline__ int crow(int r, int hi) { return (r & 3) + 8 * (r >> 2) + 4 * hi; }
__device__ __forceinline__ void glds16(const void* gsrc, unsigned lds_dst) { unsigned keep;
    asm volatile("s_mov_b32 %0, m0\n\ts_mov_b32 m0, %2\n\ts_nop 0\n\tglobal_load_lds_dwordx4 %1, off\n\ts_mov_b32 m0, %0" : "=&s"(keep) : "v"(gsrc), "s"(lds_dst) : "memory"); }
typedef float f32x2_t __attribute__((ext_vector_type(2))); typedef __bf16 bf16x2_t __attribute__((ext_vector_type(2)));
__device__ __forceinline__ unsigned cvtpk_s(float lo, float hi) { f32x2_t v = {lo, hi}; bf16x2_t b = __builtin_convertvector(v, bf16x2_t); return __builtin_bit_cast(unsigned, b); }
__device__ __forceinline__ void qkt(f32x16& p0, f32x16& p1, lds_cptr kb  , const bf16x8* qr) {
    p0 = f32x16{}; p1 = f32x16{};
#pragma unroll
    for (int d0 = 0; d0 < 4; ++d0) {
        const bf16x8 b0 = *(const LAS bf16x8*)(kb + d0 * 2048);
        const bf16x8 b1 = *(const LAS bf16x8*)(kb + d0 * 2048 + 512);
        p0 = __builtin_amdgcn_mfma_f32_32x32x16_bf16(b0, qr[d0], p0, 0, 0, 0); p1 = __builtin_amdgcn_mfma_f32_32x32x16_bf16(b1, qr[d0], p1, 0, 0, 0); }
}
__device__ __forceinline__ void pv(f32x16* o, int vb, bf16x8 pa0, bf16x8 pa1, bf16x8 pa2, bf16x8 pa3) {
#pragma unroll
    for (int d0 = 0; d0 < 2; ++d0) { s16x4 lo[4], hi[4];
#pragma unroll
        for (int ks = 0; ks < 4; ++ks) {
            asm volatile("ds_read_b64_tr_b16 %0,%1 offset:%c2" : "=&v"(lo[ks]) : "v"(vb), "i"(d0 * 4096 + ks * 1024) : "memory");
            asm volatile("ds_read_b64_tr_b16 %0,%1 offset:%c2" : "=&v"(hi[ks]) : "v"(vb), "i"(d0 * 4096 + ks * 1024 + 512) : "memory"); }
        asm volatile("s_waitcnt lgkmcnt(0)" ::: "memory"); __builtin_amdgcn_sched_barrier(0);
#define ATT_PK(k) (bf16x8){lo[k][0], lo[k][1], lo[k][2], lo[k][3], hi[k][0], hi[k][1], hi[k][2], hi[k][3]}
        o[d0] = __builtin_amdgcn_mfma_f32_32x32x16_bf16(pa0, ATT_PK(0), o[d0], 0, 0, 0);
        o[d0] = __builtin_amdgcn_mfma_f32_32x32x16_bf16(pa1, ATT_PK(1), o[d0], 0, 0, 0);
        o[d0] = __builtin_amdgcn_mfma_f32_32x32x16_bf16(pa2, ATT_PK(2), o[d0], 0, 0, 0);
        o[d0] = __builtin_amdgcn_mfma_f32_32x32x16_bf16(pa3, ATT_PK(3), o[d0], 0, 0, 0);
#undef ATT_PK
    }
}
__device__ __forceinline__ float hswap_max(float m) { auto rr = __builtin_amdgcn_permlane32_swap(__float_as_uint(m), __float_as_uint(m), false, false); return fmaxf(__uint_as_float(rr[0]), __uint_as_float(rr[1])); }
__device__ __forceinline__ float hswap_sum(float m) { auto rr = __builtin_amdgcn_permlane32_swap(__float_as_uint(m), __float_as_uint(m), false, false); return __uint_as_float(rr[0]) + __uint_as_float(rr[1]); }

struct Roll { const f32x4* sk; const f32x4* sv; f32x4* dk; f32x4* dv; };
__device__ __forceinline__ void attn_units4(int n, int qb0, int kv, const bf16* Q, const bf16* __restrict__ K, const bf16* __restrict__ V, bf16* O, const float* __restrict__ sink, LAS char* shm, const Roll rl, int rid0) {
    asm volatile("" : "+s"(n), "+s"(qb0), "+s"(kv));
    const int tid = opaque_tid(), lane = tid & 63, r32 = lane & 31, hi = lane >> 5; const int wid = __builtin_amdgcn_readfirstlane(tid >> 6);
    const int g = wid >> 1, qh = wid & 1, h = kv * 4 + g; const long rowbase = (long)n * SEQ;
    const unsigned lds0 = (unsigned)(uintptr_t)shm;
    LAS float* wsf = (LAS float*)(shm + LDS_WS) + wid * 64;
    const bf16* kbase = K + (rowbase + lane) * 256 + kv * 64 + wid * 8;
    const bf16* vbase = V + (rowbase + 16 * (wid & 3) + (lane >> 2)) * 256 + kv * 64 + (wid >> 2) * 32 + (lane & 3) * 8;
    const bf16* Qw = Q + (rowbase + qh * 32 + r32) * 1024 + h * 64 + hi * 8;
    bf16* Ow = O + (rowbase + qh * 32) * 1024 + h * 64;
    LAS bf16* stg = (LAS bf16*)(shm + LDS_OST) + wid * 2048;
    const float sk2 = sink[h] * LOG2E;
#define ATT_TILE(kt) do { const int kt_ = (kt); if (kt_ >= 0) { const int so_ = (kt_ & 3) * SLOTB + wid * 1024; \
        glds16(kbase + (long)kt_ * 64 * 256, (unsigned)__builtin_amdgcn_readfirstlane(lds0 + LDS_K + so_)); glds16(vbase + (long)kt_ * 64 * 256, (unsigned)__builtin_amdgcn_readfirstlane(lds0 + LDS_V + so_)); } } while (0)
    ATT_TILE(qb0 - 2); ATT_TILE(qb0 - 1); ATT_TILE(qb0);
    bf16x8 qr[4], qn[4];
#pragma unroll
    for (int d0 = 0; d0 < 4; ++d0) { qr[d0] = *reinterpret_cast<const bf16x8*>(Qw + (long)qb0 * 64 * 1024 + d0 * 16); qn[d0] = qr[d0]; }
    f32x4 ck0 = {}, ck1 = {}, cv0 = {}, cv1 = {}; size_t cd0 = 0, cd1 = 0; bool c0 = false, c1 = false, pend = false;
#pragma unroll 1
    for (int i = 0; i < 4; ++i) {
        const int qb = qb0 + i;
        asm volatile("s_waitcnt vmcnt(0) lgkmcnt(0)\n\ts_barrier" ::: "memory");
        if (i < 3) { ATT_TILE(qb + 1);
#pragma unroll
            for (int d0 = 0; d0 < 4; ++d0) qn[d0] = *reinterpret_cast<const bf16x8*>(Qw + (long)(qb + 1) * 64 * 1024 + d0 * 16); }
        if (pend) {
#pragma unroll
            for (int j = 0; j < 4; ++j) { const int row = j * 8 + (lane >> 3), ch = lane & 7; const u32x4 v = *(const LAS u32x4*)(stg + row * 64 + ch * 8); *(u32x4*)(Ow + ((long)(qb - 1) * 64 + row) * 1024 + ch * 8) = v; }
            if (c0) { rl.dk[cd0] = ck0; rl.dv[cd0] = cv0; }
            if (c1) { rl.dk[cd1] = ck1; rl.dv[cd1] = cv1; }
            asm volatile("s_waitcnt lgkmcnt(0)" ::: "memory"); }
        c0 = false; c1 = false;
        if (rid0 >= 0) { const int e0 = (rid0 + i) * 512 + tid, e1 = e0 + 1024 * 512;
            c0 = true; { const int nn = e0 / (127 * 64); cd0 = (size_t)nn * 128 * 64 + (e0 - nn * (127 * 64)); ck0 = rl.sk[cd0 + 64]; cv0 = rl.sv[cd0 + 64]; }
            c1 = e1 < 128 * 127 * 64; if (c1) { const int nn = e1 / (127 * 64); cd1 = (size_t)nn * 128 * 64 + (e1 - nn * (127 * 64)); ck1 = rl.sk[cd1 + 64]; cv1 = rl.sv[cd1 + 64]; } }
        const int jlo = qb == 0 ? 2 : (qb == 1 ? 1 : 0);
        const int s0 = ((qb - 2) & 3) * SLOTB, s1 = ((qb - 1) & 3) * SLOTB, s2 = (qb & 3) * SLOTB;
        const lds_cptr kp0 = (lds_cptr)shm + LDS_K + hi * 1024 + r32 * 16;
        const int vb0 = (int)(lds0 + LDS_V) + ((lane >> 4) & 1) * 32 + (lane & 3) * 8 + (4 * hi + ((lane & 15) >> 2)) * 64;
        const float NEG = -INFINITY;
        f32x16 p00, p01, p10, p11, p20, p21;
        if (jlo <= 0) qkt(p00, p01, kp0 + s0, qr); else { for (int r = 0; r < 16; ++r) { p00[r] = NEG; p01[r] = NEG; } }
        if (jlo <= 1) qkt(p10, p11, kp0 + s1, qr); else { for (int r = 0; r < 16; ++r) { p10[r] = NEG; p11[r] = NEG; } }
        qkt(p20, p21, kp0 + s2, qr);
        const int qrel = qh * 32 + r32;
#pragma unroll
        for (int r = 0; r < 16; ++r) { const int kk = crow(r, hi);
            if (kk < qrel + 1) p00[r] = NEG; if (kk + 32 < qrel + 1) p01[r] = NEG;
            if (kk > qrel) p20[r] = NEG; if (kk + 32 > qrel) p21[r] = NEG; }
        float mx = sk2;
#pragma unroll
        for (int r = 0; r < 16; ++r) { mx = fmaxf(fmaxf(mx, p00[r]), p01[r]); mx = fmaxf(fmaxf(mx, p10[r]), p11[r]); mx = fmaxf(fmaxf(mx, p20[r]), p21[r]); }
        mx = hswap_max(mx);
        f32x2_t ls2 = {0.f, 0.f}; const f32x2_t mx2 = {mx, mx};
#define ATT_EXP2(P) do { _Pragma("unroll") for (int r = 0; r < 16; r += 2) { const f32x2_t d_ = (f32x2_t){P[r], P[r + 1]} - mx2; \
            const f32x2_t e_ = {__builtin_amdgcn_exp2f(d_.x), __builtin_amdgcn_exp2f(d_.y)}; P[r] = e_.x; P[r + 1] = e_.y; ls2 += e_; } } while (0)
        ATT_EXP2(p00); ATT_EXP2(p01); ATT_EXP2(p10); ATT_EXP2(p11); ATT_EXP2(p20); ATT_EXP2(p21);
#undef ATT_EXP2
        float ls = ls2.x + ls2.y;
        ls = hswap_sum(ls) + __builtin_amdgcn_exp2f(sk2 - mx);
        f32x16 o[2]; o[0] = f32x16{}; o[1] = f32x16{};
#define ATT_PKW(P, B) cvtpk_s(P[B], P[B + 1])
#define ATT_PVT(PA, PB, SO) do { const u32x4 w0 = (u32x4){ATT_PKW(PA, 0), ATT_PKW(PA, 2), ATT_PKW(PA, 4), ATT_PKW(PA, 6)}, w1 = (u32x4){ATT_PKW(PA, 8), ATT_PKW(PA, 10), ATT_PKW(PA, 12), ATT_PKW(PA, 14)}, \
        w2 = (u32x4){ATT_PKW(PB, 0), ATT_PKW(PB, 2), ATT_PKW(PB, 4), ATT_PKW(PB, 6)}, w3 = (u32x4){ATT_PKW(PB, 8), ATT_PKW(PB, 10), ATT_PKW(PB, 12), ATT_PKW(PB, 14)}; \
        pv(o, vb0 + (SO), __builtin_bit_cast(bf16x8, w0), __builtin_bit_cast(bf16x8, w1), __builtin_bit_cast(bf16x8, w2), __builtin_bit_cast(bf16x8, w3)); } while (0)
        if (jlo <= 0) ATT_PVT(p00, p01, s0);
        if (jlo <= 1) ATT_PVT(p10, p11, s1);
        ATT_PVT(p20, p21, s2);
#undef ATT_PVT
#undef ATT_PKW
        if (hi == 0) wsf[32 + r32] = ls; asm volatile("s_waitcnt lgkmcnt(0)" ::: "memory");
        float rli[16];
#pragma unroll
        for (int r = 0; r < 16; ++r) rli[r] = __builtin_amdgcn_rcpf(wsf[32 + crow(r, hi)]);
#pragma unroll
        for (int r = 0; r < 16; ++r) { const int orow = crow(r, hi);
#pragma unroll
            for (int d0 = 0; d0 < 2; ++d0) stg[orow * 64 + d0 * 32 + r32] = (bf16)f2bf(o[d0][r] * rli[r]); }
        pend = true;
#pragma unroll
        for (int d0 = 0; d0 < 4; ++d0) qr[d0] = qn[d0];
    }
#undef ATT_TILE
    asm volatile("s_waitcnt lgkmcnt(0)" ::: "memory");
#pragma unroll
    for (int j = 0; j < 4; ++j) { const int row = j * 8 + (lane >> 3), ch = lane & 7; const u32x4 v = *(const LAS u32x4*)(stg + row * 64 + ch * 8); *(u32x4*)(Ow + ((long)(qb0 + 3) * 64 + row) * 1024 + ch * 8) = v; }
    if (c0) { rl.dk[cd0] = ck0; rl.dv[cd0] = cv0; }
    if (c1) { rl.dk[cd1] = ck1; rl.dv[cd1] = cv1; }
    asm volatile("s_waitcnt lgkmcnt(0)\n\ts_barrier" ::: "memory");
}
}
namespace ssm {
using f32x16 = __attribute__((ext_vector_type(16))) float;
using s16x4 = __attribute__((ext_vector_type(4))) short;
constexpr int XT_PITCH = 144, XT_BYTES = 128 * XT_PITCH, WREG = XT_BYTES + 256;
constexpr size_t T_AB = 0, T_BBT = 32768, T_CCT = T_BBT + 262144, T_DG = T_CCT + 262144, T_BYTES = 1u << 20;
__device__ __forceinline__ float fma_s(float a, float b, float c) { float r; asm("v_fma_f32 %0, %1, %2, %3" : "=v"(r) : "v"(a), "v"(b), "v"(c)); return r; }
__device__ __forceinline__ float mul_s(float a, float b) { float r; asm("v_mul_f32_e32 %0, %1, %2" : "=v"(r) : "v"(a), "v"(b)); return r; }
__device__ __forceinline__ float cstep(float p_, float a, float q, float b, float s_, float d) { float r; asm("v_mul_f32_e32 %0, %5, %6\n\tv_fma_f32 %0, %3, %4, %0\n\tv_fma_f32 %0, %1, %2, %0" : "=&v"(r) : "v"(p_), "v"(a), "v"(q), "v"(b), "v"(s_), "v"(d)); return r; }
__device__ __forceinline__ void cstep4(float& x0r, float& x0i, float& x1r, float& x1i, float a0x, float a0y, float na0y, float a1x, float a1y, float na1y, float s_, float d0_, float d2_, float d1_, float d3_) {
    float n0r, n0i, n1r, n1i;
    asm("v_mul_f32_e32 %0, %14, %15\n\tv_mul_f32_e32 %1, %14, %16\n\tv_mul_f32_e32 %2, %14, %17\n\tv_mul_f32_e32 %3, %14, %18\n\t"
        "v_fma_f32 %0, %6, %11, %0\n\tv_fma_f32 %1, %5, %10, %1\n\tv_fma_f32 %2, %9, %13, %2\n\tv_fma_f32 %3, %8, %12, %3\n\t"
        "v_fma_f32 %0, %4, %10, %0\n\tv_fma_f32 %1, %4, %11, %1\n\tv_fma_f32 %2, %7, %12, %2\n\tv_fma_f32 %3, %7, %13, %3"
        : "=&v"(n0r), "=&v"(n0i), "=&v"(n1r), "=&v"(n1i)
        : "v"(a0x), "v"(a0y), "v"(na0y), "v"(a1x), "v"(a1y), "v"(na1y), "v"(x0r), "v"(x0i), "v"(x1r), "v"(x1i), "v"(s_), "v"(d0_), "v"(d2_), "v"(d1_), "v"(d3_));
    x0r = n0r; x0i = n0i; x1r = n1r; x1i = n1i;
}
__device__ __forceinline__ int tokmap(int T, int i) { return 32 * ((i >> 2) & 1) + 16 * T + 4 * (i >> 3) + (i & 3); }

struct Tab { const float* ab; const bf16* bbt; const bf16* cct; const float* dg; };
__device__ __forceinline__ Tab tab_of(unsigned char* ws, int jm) { unsigned char* b = ws + WS_SSM + (size_t)jm * T_BYTES; return Tab{(const float*)(b + T_AB), (const bf16*)(b + T_BBT), (const bf16*)(b + T_CCT), (const float*)(b + T_DG)}; }

__device__ __forceinline__ void build_tables(unsigned char* ws, int jm, int gp, const float* a_re, const float* a_im, const float* log_dt, const float* b_re, const float* b_im,
                                             const float* c_re, const float* c_im, const float* dsk, const float* gain) {
    unsigned char* b = ws + WS_SSM + (size_t)jm * T_BYTES;
    float* AB = (float*)(b + T_AB); bf16* BBT = (bf16*)(b + T_BBT); bf16* CCT = (bf16*)(b + T_CCT); float* DG = (float*)(b + T_DG);
    const int g = gp >> 6, p = gp & 63;
    const float dt = expf(log_dt[g]), ar = a_re[gp], ai = a_im[gp];
    const float mag = expf(ar * dt); float sn, cs; sincosf(ai * dt, &sn, &cs);
    const float abr = mag * cs, abi = mag * sn, den = ar * ar + ai * ai;
    const float cr = ((abr - 1.0f) * ar + abi * ai) / den, ci = (abi * ar - (abr - 1.0f) * ai) / den;
    *(float2*)(AB + 2 * gp) = make_float2(abr, abi);
    const float4* br4 = (const float4*)(b_re + (size_t)gp * 16); const float4* bi4 = (const float4*)(b_im + (size_t)gp * 16); const float4* gn4 = (const float4*)(gain + g * 16);
    uint4* dre = (uint4*)(BBT + ((size_t)g * 128 + p) * 16); uint4* dim = (uint4*)(BBT + ((size_t)g * 128 + 64 + p) * 16);
#pragma unroll
    for (int h = 0; h < 2; ++h) {
        const float4 r0 = br4[2 * h], r1 = br4[2 * h + 1], i0 = bi4[2 * h], i1 = bi4[2 * h + 1], g0 = gn4[2 * h], g1 = gn4[2 * h + 1];
        uint4 vr, vi;
        vr.x = pk2((cr * r0.x - ci * i0.x) * g0.x, (cr * r0.y - ci * i0.y) * g0.y); vr.y = pk2((cr * r0.z - ci * i0.z) * g0.z, (cr * r0.w - ci * i0.w) * g0.w);
        vr.z = pk2((cr * r1.x - ci * i1.x) * g1.x, (cr * r1.y - ci * i1.y) * g1.y); vr.w = pk2((cr * r1.z - ci * i1.z) * g1.z, (cr * r1.w - ci * i1.w) * g1.w);
        vi.x = pk2((cr * i0.x + ci * r0.x) * g0.x, (cr * i0.y + ci * r0.y) * g0.y); vi.y = pk2((cr * i0.z + ci * r0.z) * g0.z, (cr * i0.w + ci * r0.w) * g0.w);
        vi.z = pk2((cr * i1.x + ci * r1.x) * g1.x, (cr * i1.y + ci * r1.y) * g1.y); vi.w = pk2((cr * i1.z + ci * r1.z) * g1.z, (cr * i1.w + ci * r1.w) * g1.w);
        dre[h] = vr; dim[h] = vi;
    }
    for (int c = 0; c < 16; ++c) {
        CCT[((size_t)g * 16 + c) * 128 + p] = (bf16)f2bf(c_re[((size_t)g * 16 + c) * 64 + p]);
        CCT[((size_t)g * 16 + c) * 128 + 64 + p] = (bf16)f2bf(-c_im[((size_t)g * 16 + c) * 64 + p]);
    }
    if (p < 16) DG[g * 16 + p] = dsk[g * 16 + p] * gain[g * 16 + p];
}

template <bool FINAL>
__device__ __forceinline__ void unit(int n, int chunk, const Tab T, const bf16* __restrict__ XB, const float* __restrict__ SS, f32x2* __restrict__ EC, bf16* __restrict__ Z, LAS unsigned char* L) {
    const int tid = opaque_tid(), lane = tid & 63, r32 = lane & 31, hi = lane >> 5; const int wave = __builtin_amdgcn_readfirstlane(tid >> 6);
    LAS unsigned char* wl = L + wave * WREG; LAS float* rsb = (LAS float*)(wl + XT_BYTES);
    const int row0 = n * SEQ + chunk * 64;
    { const f32x4* p = (const f32x4*)(SS + (size_t)(row0 + lane) * 32); float s = 0.f;
#pragma unroll
      for (int i = 0; i < 4; ++i) { const f32x4 t = p[i]; s += (t[0] + t[1]) + (t[2] + t[3]); }
      rsb[lane] = __builtin_amdgcn_rsqf(s * (1.0f / 1024.0f) + 1e-6f); }
    LDS_WAIT(); asm volatile("" ::: "memory");
    const int run = 2 * chunk + hi;
    bf16x8 a_n[2], b_n[4]; f32x2 A0_n, A1_n, c0_n = {0.f, 0.f}, c1_n = {0.f, 0.f};
#define SSM_LOAD(G) do { _Pragma("unroll") for (int t = 0; t < 2; ++t) a_n[t] = *(const bf16x8*)(XB + (size_t)(row0 + tokmap(t, r32)) * 1024 + (G) * 16 + 8 * hi); \
        _Pragma("unroll") for (int cb = 0; cb < 4; ++cb) b_n[cb] = *(const bf16x8*)(T.bbt + ((size_t)(G) * 128 + 32 * cb + r32) * 16 + 8 * hi); \
        A0_n = *(const f32x2*)(T.ab + 2 * ((G) * 64 + r32)); A1_n = *(const f32x2*)(T.ab + 2 * ((G) * 64 + 32 + r32)); \
        if (FINAL) { const f32x2* ec_ = EC + ((size_t)(n * 128 + run) * 64 + (G)) * 64; c0_n = ec_[r32]; c1_n = ec_[32 + r32]; } } while (0)
    SSM_LOAD(wave * 8);
#pragma unroll 1
    for (int gi = 0; gi < 8; ++gi) {
        const int g = wave * 8 + gi;
        bf16x8 a[2], b[4];
#pragma unroll
        for (int t = 0; t < 2; ++t) a[t] = a_n[t];
#pragma unroll
        for (int cb = 0; cb < 4; ++cb) b[cb] = b_n[cb];
        const f32x2 A0 = A0_n, A1 = A1_n; const f32x2 c0 = c0_n, c1 = c1_n;
        v2u xwc[4]; bf16x8 ca[4];
        if (FINAL) {
#pragma unroll
            for (int tt = 0; tt < 4; ++tt) { xwc[tt] = *(const v2u*)(XB + (size_t)(row0 + 16 * tt + (lane & 15)) * 1024 + g * 16 + 4 * (lane >> 4)); ca[tt] = *(const bf16x8*)(T.cct + ((size_t)g * 16 + (lane & 15)) * 128 + 32 * tt + 8 * (lane >> 4)); }
        }
        if (gi < 7) SSM_LOAD(g + 1);
        float x0r = c0.x, x0i = c0.y, x1r = c1.x, x1i = c1.y;
        f32x2* ec = EC + ((size_t)(n * 128 + run) * 64 + g) * 64;
#pragma unroll
        for (int t = 0; t < 2; ++t) {
            float rs[16];
#pragma unroll
            for (int k = 0; k < 4; ++k) { const f32x4 tq = *(const LAS f32x4*)(rsb + 32 * hi + 16 * t + 4 * k); rs[4 * k] = tq[0]; rs[4 * k + 1] = tq[1]; rs[4 * k + 2] = tq[2]; rs[4 * k + 3] = tq[3]; }
            const f32x16 z16 = f32x16{};
            f32x16 d0 = __builtin_amdgcn_mfma_f32_32x32x16_bf16(a[t], b[0], z16, 0, 0, 0), d1 = __builtin_amdgcn_mfma_f32_32x32x16_bf16(a[t], b[1], z16, 0, 0, 0);
            f32x16 d2 = __builtin_amdgcn_mfma_f32_32x32x16_bf16(a[t], b[2], z16, 0, 0, 0), d3 = __builtin_amdgcn_mfma_f32_32x32x16_bf16(a[t], b[3], z16, 0, 0, 0);
            asm volatile("s_nop 15\n\ts_nop 7" : "+v"(d0), "+v"(d1), "+v"(d2), "+v"(d3));
            const float nA0y = -A0.y, nA1y = -A1.y;
#pragma unroll
            for (int hf = 0; hf < 2; ++hf) {
                float o0r[8], o0i[8], o1r[8], o1i[8];
#pragma unroll
                for (int r8 = 0; r8 < 8; ++r8) {
                    const int r = 8 * hf + r8; const float s = rs[r];
                    cstep4(x0r, x0i, x1r, x1i, A0.x, A0.y, nA0y, A1.x, A1.y, nA1y, s, d0[r], d2[r], d1[r], d3[r]);
                    const float n0r = x0r, n0i = x0i, n1r = x1r, n1i = x1i;
                    if (FINAL) { o0r[r8] = n0r; o0i[r8] = n0i; o1r[r8] = n1r; o1i[r8] = n1i; }
                }
                if (FINAL) {
                    const int cofs = (32 * hi + 16 * t + 8 * hf) * 2;
                    v4u w0, w1, w2, w3;
                    w0.x = pg8::cvt_pk_bf16(o0r[0], o0r[1]); w0.y = pg8::cvt_pk_bf16(o0r[2], o0r[3]); w0.z = pg8::cvt_pk_bf16(o0r[4], o0r[5]); w0.w = pg8::cvt_pk_bf16(o0r[6], o0r[7]);
                    w1.x = pg8::cvt_pk_bf16(o1r[0], o1r[1]); w1.y = pg8::cvt_pk_bf16(o1r[2], o1r[3]); w1.z = pg8::cvt_pk_bf16(o1r[4], o1r[5]); w1.w = pg8::cvt_pk_bf16(o1r[6], o1r[7]);
                    w2.x = pg8::cvt_pk_bf16(o0i[0], o0i[1]); w2.y = pg8::cvt_pk_bf16(o0i[2], o0i[3]); w2.z = pg8::cvt_pk_bf16(o0i[4], o0i[5]); w2.w = pg8::cvt_pk_bf16(o0i[6], o0i[7]);
                    w3.x = pg8::cvt_pk_bf16(o1i[0], o1i[1]); w3.y = pg8::cvt_pk_bf16(o1i[2], o1i[3]); w3.z = pg8::cvt_pk_bf16(o1i[4], o1i[5]); w3.w = pg8::cvt_pk_bf16(o1i[6], o1i[7]);
                    *(LAS v4u*)(wl + (r32) * XT_PITCH + cofs) = w0; *(LAS v4u*)(wl + (32 + r32) * XT_PITCH + cofs) = w1;
                    *(LAS v4u*)(wl + (64 + r32) * XT_PITCH + cofs) = w2; *(LAS v4u*)(wl + (96 + r32) * XT_PITCH + cofs) = w3;
                    asm volatile("s_nop 1" ::: "memory"); __builtin_amdgcn_sched_barrier(0);
                }
            }
        }
        if (!FINAL) { const f32x2 e0 = {x0r, x0i}, e1 = {x1r, x1i}; pg8::st_b64(ec + r32, __builtin_bit_cast(v2u, e0)); pg8::st_b64(ec + 32 + r32, __builtin_bit_cast(v2u, e1)); }
        else {
            LDS_WAIT(); asm volatile("" ::: "memory");
            const int i16 = lane & 15, kq = lane >> 4;
            const f32x4 dg = *(const f32x4*)(T.dg + g * 16 + 4 * kq);
            const unsigned trb = (unsigned)(uintptr_t)wl + (8 * kq + (i16 >> 2)) * XT_PITCH + (4 * (i16 & 3)) * 2;
            s16x4 lo[4][4], hh[4][4];
#pragma unroll
            for (int tt = 0; tt < 4; ++tt)
#pragma unroll
                for (int ks = 0; ks < 4; ++ks) {
                    asm volatile("ds_read_b64_tr_b16 %0,%1 offset:%c2" : "=&v"(lo[tt][ks]) : "v"(trb), "i"(ks * 32 * XT_PITCH + tt * 32) : "memory");
                    asm volatile("ds_read_b64_tr_b16 %0,%1 offset:%c2" : "=&v"(hh[tt][ks]) : "v"(trb), "i"(ks * 32 * XT_PITCH + 4 * XT_PITCH + tt * 32) : "memory"); }
            asm volatile("s_waitcnt lgkmcnt(0)" ::: "memory"); __builtin_amdgcn_sched_barrier(0);
            f32x4 acc4[4];
#pragma unroll
            for (int tt = 0; tt < 4; ++tt) acc4[tt] = (f32x4){0.f, 0.f, 0.f, 0.f};
#pragma unroll
            for (int ks = 0; ks < 4; ++ks)
#pragma unroll
                for (int tt = 0; tt < 4; ++tt) { const bf16x8 bb = (bf16x8){lo[tt][ks][0], lo[tt][ks][1], lo[tt][ks][2], lo[tt][ks][3], hh[tt][ks][0], hh[tt][ks][1], hh[tt][ks][2], hh[tt][ks][3]};
                    acc4[tt] = __builtin_amdgcn_mfma_f32_16x16x32_bf16(ca[ks], bb, acc4[tt], 0, 0, 0); }
#pragma unroll
            for (int tt = 0; tt < 4; ++tt) {
                const f32x4 acc = acc4[tt];
                const int tok = 16 * tt + i16; const size_t row = (size_t)(row0 + tok);
                const v2u xw = xwc[tt];
                const float rt = rsb[tok];
                const float h0 = __builtin_bit_cast(float, xw.x << 16), h1 = __builtin_bit_cast(float, xw.x & 0xffff0000u), h2 = __builtin_bit_cast(float, xw.y << 16), h3 = __builtin_bit_cast(float, xw.y & 0xffff0000u);
                const f32x2 dr0 = {dg[0] * rt, dg[1] * rt}, dr1 = {dg[2] * rt, dg[3] * rt};
                f32x2 ya = (f32x2){acc[0], acc[1]} + dr0 * (f32x2){h0, h1}, yb = (f32x2){acc[2], acc[3]} + dr1 * (f32x2){h2, h3};
                const f32x2 ua = (ya * ya * 0.044715f + 1.0f) * ya * (-1.5957691216057308f * LOG2E), ub = (yb * yb * 0.044715f + 1.0f) * yb * (-1.5957691216057308f * LOG2E);
                f32x2 ea, eb; ea.x = __builtin_amdgcn_exp2f(ua.x); ea.y = __builtin_amdgcn_exp2f(ua.y); eb.x = __builtin_amdgcn_exp2f(ub.x); eb.y = __builtin_amdgcn_exp2f(ub.y);
                ea = ea + 1.0f; eb = eb + 1.0f;
                f32x2 ra, rb; ra.x = __builtin_amdgcn_rcpf(ea.x); ra.y = __builtin_amdgcn_rcpf(ea.y); rb.x = __builtin_amdgcn_rcpf(eb.x); rb.y = __builtin_amdgcn_rcpf(eb.y);
                ya = ya * ra; yb = yb * rb;
                v2u zw; zw.x = pg8::cvt_pk_bf16(ya.x, ya.y); zw.y = pg8::cvt_pk_bf16(yb.x, yb.y);
                pg8::st_b64(Z + row * 1024 + g * 16 + 4 * kq, zw);
            }
            LDS_WAIT(); asm volatile("" ::: "memory");
        }
    }
}

__device__ __forceinline__ void carries(int vcu, int G, const Tab T, const f32x2* __restrict__ E, f32x2* __restrict__ CIN, float* __restrict__ out_re, float* __restrict__ out_im) {
    const int tid = opaque_tid(), lane = tid & 63, j = lane >> 3;
    for (int wv = vcu * 8 + (tid >> 6); wv < 2048; wv += G * 8) {
        const int Lb = wv * 8 + (lane & 7), n = Lb >> 12, gp = Lb & 4095;
        f32x2 A = *(const f32x2*)(T.ab + 2 * gp);
#pragma unroll
        for (int s = 0; s < 5; ++s) A = f32x2{A.x * A.x - A.y * A.y, 2.f * A.x * A.y};
        f32x2 loc[16]; f32x2 c = {0.f, 0.f};
        const f32x2* e = E + ((size_t)(n * 128 + 16 * j)) * 4096 + gp;
#pragma unroll
        for (int k = 0; k < 16; ++k) { loc[k] = c; const f32x2 ev = e[(size_t)k * 4096]; c = f32x2{A.x * c.x - A.y * c.y + ev.x, A.x * c.y + A.y * c.x + ev.y}; }
        f32x2 P = A;
#pragma unroll
        for (int s = 0; s < 4; ++s) P = f32x2{P.x * P.x - P.y * P.y, 2.f * P.x * P.y};
        f32x2 carry = {0.f, 0.f}, mine = {0.f, 0.f};
#pragma unroll
        for (int i = 0; i < 8; ++i) { const float er = __shfl(c.x, (lane & 7) + 8 * i), ei = __shfl(c.y, (lane & 7) + 8 * i); if (i == j) mine = carry;
            carry = f32x2{P.x * carry.x - P.y * carry.y + er, P.x * carry.y + P.y * carry.x + ei}; }
        if (j == 0) { out_re[(size_t)n * 4096 + gp] = carry.x; out_im[(size_t)n * 4096 + gp] = carry.y; }
        f32x2 pw = {1.f, 0.f}; f32x2* o = CIN + ((size_t)(n * 128 + 16 * j)) * 4096 + gp;
#pragma unroll
        for (int k = 0; k < 16; ++k) { o[(size_t)k * 4096] = f32x2{loc[k].x + pw.x * mine.x - pw.y * mine.y, loc[k].y + pw.x * mine.y + pw.y * mine.x}; pw = f32x2{pw.x * A.x - pw.y * A.y, pw.x * A.y + pw.y * A.x}; }
    }
}
#undef SSM_LOAD
}
namespace sg {
constexpr size_t WS_SSS = WS_SSM + 34 * MiB;
constexpr size_t WS_QKVS = WS_SSS + 65536;
enum { M_QKV = 0, M_RES = 1, M_GLU = 2, M_UP = 3 };
struct P { float* x; bf16* xb; float* sss; float* qkvs; bf16* act; const float* cw; const float* cb; const float* stc; float* cso; };
__device__ __forceinline__ float rs_of(const float* sss, int t) { const f32x4* p = (const f32x4*)(sss + t * 64); float s = 0.f;
#pragma unroll
    for (int i = 0; i < 16; ++i) { const f32x4 v = p[i]; s += (v[0] + v[1]) + (v[2] + v[3]); }
    return 1.0f / sqrtf(s * (1.0f / 1024.0f) + 1e-6f); }
__device__ __forceinline__ float rs_of4(const float* sss, int t, int kq) { const f32x4* p = (const f32x4*)(sss + t * 64 + 16 * kq); float s = 0.f;
#pragma unroll
    for (int i = 0; i < 4; ++i) { const f32x4 v = p[i]; s += (v[0] + v[1]) + (v[2] + v[3]); }
    s += __shfl_xor(s, 16); s += __shfl_xor(s, 32);
    return 1.0f / sqrtf(s * (1.0f / 1024.0f) + 1e-6f); }
template <int MODE, int KK, int NT>
__device__ __forceinline__ void unit(int uu, const bf16* __restrict__ Xs, const bf16* __restrict__ Wt, const P p, LAS unsigned char* L) {
    constexpr bool PAIRED = (MODE == M_GLU || MODE == M_UP);
    constexpr int NTG = 8 / NT, NKS = KK / 256;
    const int u = uu / NTG, tg = uu % NTG;
    const int tid = opaque_tid(), lane = tid & 63, i16 = lane & 15, kq = lane >> 4; const int wave = __builtin_amdgcn_readfirstlane(tid >> 6);
    const int rA = PAIRED ? (256 * (u >> 3) + 16 * (u & 7)) : 16 * u;
    const bf16* wa = Wt + (size_t)(rA + i16) * KK + wave * (KK / 8) + 8 * kq;
    const bf16* xa = Xs + (size_t)(16 * NT * tg + i16) * KK + wave * (KK / 8) + 8 * kq;
    const int tE = 16 * (NT * tg + (wave < NT ? wave : 0)) + i16;
    const int cE = MODE == M_RES ? 256 * (u >> 4) + 128 * ((u >> 3) & 1) + 32 * ((u >> 1) & 3) + 4 * (u & 1) + 8 * kq : 128 * (u >> 3) + 32 * ((u & 7) >> 1) + 4 * (u & 1) + 8 * kq;
    f32x4 pre0 = (f32x4){0.f, 0.f, 0.f, 0.f}, pre1 = pre0, pre2 = pre0, pre3 = pre0; float preR = 0.f;
    if (wave < NT) {
        if (MODE == M_RES || MODE == M_GLU) pre0 = *(const f32x4*)(p.x + (size_t)tE * 1024 + cE);
        if (MODE == M_UP) { const float* s0 = p.stc + (size_t)tE * 2 * 5632;
            pre0 = *(const f32x4*)(s0 + cE); pre1 = *(const f32x4*)(s0 + 5632 + cE); pre2 = *(const f32x4*)(s0 + 2816 + cE); pre3 = *(const f32x4*)(s0 + 5632 + 2816 + cE); preR = rs_of4(p.sss, tE, kq); }
    }
    f32x4 acc[NT], accB[NT];
#pragma unroll
    for (int m = 0; m < NT; ++m) { acc[m] = (f32x4){0.f, 0.f, 0.f, 0.f}; accB[m] = (f32x4){0.f, 0.f, 0.f, 0.f}; }
    bf16x8 wf[NKS], wg[NKS];
#pragma unroll
    for (int ks = 0; ks < NKS; ++ks) { wf[ks] = *(const bf16x8*)(wa + 32 * ks); if (PAIRED) wg[ks] = *(const bf16x8*)(wa + (size_t)128 * KK + 32 * ks); }
    constexpr int MB = (NKS <= 4) ? (NT >= 4 ? 4 : NT) : (NT * NKS <= 24 ? NT : 1);
#pragma unroll
    for (int m0 = 0; m0 < NT; m0 += MB) {
        bf16x8 xf[MB][NKS];
#pragma unroll
        for (int mm = 0; mm < MB; ++mm)
#pragma unroll
            for (int ks = 0; ks < NKS; ++ks) xf[mm][ks] = *(const bf16x8*)(xa + (size_t)(16 * (m0 + mm)) * KK + 32 * ks);
#pragma unroll
        for (int mm = 0; mm < MB; ++mm)
#pragma unroll
            for (int ks = 0; ks < NKS; ++ks) { acc[m0 + mm] = __builtin_amdgcn_mfma_f32_16x16x32_bf16(wf[ks], xf[mm][ks], acc[m0 + mm], 0, 0, 0);
                if (PAIRED) accB[m0 + mm] = __builtin_amdgcn_mfma_f32_16x16x32_bf16(wg[ks], xf[mm][ks], accB[m0 + mm], 0, 0, 0); }
    }
    LAS f32x4* red = (LAS f32x4*)L;
#pragma unroll
    for (int m = 0; m < NT; ++m) { red[(wave * NT + m) * 64 + lane] = acc[m]; if (PAIRED) red[4096 + (wave * NT + m) * 64 + lane] = accB[m]; }
    __syncthreads();
    if (wave < NT) {
    f32x4 ta = (f32x4){0.f, 0.f, 0.f, 0.f}, tb = (f32x4){0.f, 0.f, 0.f, 0.f};
#pragma unroll
    for (int v = 0; v < 8; ++v) { ta += red[(v * NT + wave) * 64 + lane]; if (PAIRED) tb += red[4096 + (v * NT + wave) * 64 + lane]; }
    const int t = 16 * (NT * tg + wave) + i16;
    if (MODE == M_QKV) {
        const int n0 = 256 * (u >> 4) + 64 * ((u >> 1) & 3) + 32 * ((u >> 3) & 1) + 4 * (u & 1) + 8 * kq;
        *(f32x4*)(p.qkvs + (size_t)t * 1536 + n0) = ta * rs_of4(p.sss, t, kq);
    } else if (MODE == M_RES || MODE == M_GLU) {
        const int c = (MODE == M_RES ? 256 * (u >> 4) + 128 * ((u >> 3) & 1) + 32 * ((u >> 1) & 3) + 4 * (u & 1) : 128 * (u >> 3) + 32 * ((u & 7) >> 1) + 4 * (u & 1)) + 8 * kq;
        float* xr = p.x + (size_t)t * 1024 + c; f32x4 o = pre0;
        if (MODE == M_RES) o += ta;
        else {
#pragma unroll
            for (int e = 0; e < 4; ++e) o[e] += ta[e] * __builtin_amdgcn_rcpf(1.0f + __builtin_amdgcn_exp2f(-LOG2E * tb[e])); }
        *(f32x4*)xr = o; v2u w; w.x = pk2(o[0], o[1]); w.y = pk2(o[2], o[3]); *(v2u*)(p.xb + (size_t)t * 1024 + c) = w;
        float s = (o[0] * o[0] + o[1] * o[1]) + (o[2] * o[2] + o[3] * o[3]); s += __shfl_xor(s, 16); s += __shfl_xor(s, 32);
        if (kq == 0) p.sss[t * 64 + u] = s;
    } else {
        const int j = 128 * (u >> 3) + 32 * ((u & 7) >> 1) + 4 * (u & 1) + 8 * kq;
        const float r = preR;
        const f32x4 ug = ta * r, uv = tb * r;
        const float* s0 = p.stc + (size_t)t * 2 * 5632; float* so = p.cso + (size_t)t * 2 * 5632;
        const f32x4 b0g = pre0, b1g = pre1, b0v = pre2, b1v = pre3;
        const f32x4 cg = *(const f32x4*)(p.cb + j) + *(const f32x4*)(p.cw + j) * b0g + *(const f32x4*)(p.cw + 5632 + j) * b1g + *(const f32x4*)(p.cw + 2 * 5632 + j) * ug;
        const f32x4 cv = *(const f32x4*)(p.cb + 2816 + j) + *(const f32x4*)(p.cw + 2816 + j) * b0v + *(const f32x4*)(p.cw + 5632 + 2816 + j) * b1v + *(const f32x4*)(p.cw + 2 * 5632 + 2816 + j) * uv;
        f32x4 o;
#pragma unroll
        for (int e = 0; e < 4; ++e) o[e] = cg[e] * __builtin_amdgcn_rcpf(1.0f + __builtin_amdgcn_exp2f(-LOG2E * cg[e])) * cv[e];
        v2u w; w.x = pk2(o[0], o[1]); w.y = pk2(o[2], o[3]); *(v2u*)(p.act + (size_t)t * 2816 + j) = w;
        *(f32x4*)(so + j) = b1g; *(f32x4*)(so + 2816 + j) = b1v; *(f32x4*)(so + 5632 + j) = ug; *(f32x4*)(so + 5632 + 2816 + j) = uv;
    }
    }
    __syncthreads();
}

__device__ __forceinline__ void attn_pairs(int pid0, const float* __restrict__ qkvs, const float* __restrict__ ck, const float* __restrict__ cv, const float* __restrict__ qg, const float* __restrict__ kg,
                                           const float* __restrict__ sink, bf16* __restrict__ o, float* __restrict__ kso, float* __restrict__ vso, LAS unsigned char* L) {
    const int tid = opaque_tid(), lane = tid & 63; const int wave = __builtin_amdgcn_readfirstlane(tid >> 6);
    const int slot = wave >> 2, g = wave & 3, pid = pid0 + slot, n = pid >> 2, kv = pid & 3, h = kv * 4 + g;
    const int kk = lane >> 2, dq = lane & 3;
    LAS unsigned char* Kl = L + slot * 65536; LAS unsigned char* Vl = Kl + 32768;
    { const unsigned kb = (unsigned)(uintptr_t)Kl + (32 * g) * 256, vb = (unsigned)(uintptr_t)Vl + (32 * g) * 256;
#pragma unroll
      for (int i = 0; i < 8; ++i) { int r = 32 * g + 4 * i + (lane >> 4); r = r < 127 ? r + 1 : 127;
          const size_t off = ((size_t)(n * 128 + r) * 4 + kv) * 64 + (lane & 15) * 4;
          att::glds16(ck + off, (unsigned)__builtin_amdgcn_readfirstlane(kb + i * 1024)); att::glds16(cv + off, (unsigned)__builtin_amdgcn_readfirstlane(vb + i * 1024)); } }
    const float* row = qkvs + (size_t)n * 1536;
    f32x4 q[4], kn[4], vn[4]; float sq = 0.f, sk = 0.f;
#pragma unroll
    for (int i = 0; i < 4; ++i) { q[i] = *(const f32x4*)(row + h * 64 + 16 * dq + 4 * i); kn[i] = *(const f32x4*)(row + 1024 + kv * 64 + 16 * dq + 4 * i); vn[i] = *(const f32x4*)(row + 1280 + kv * 64 + 16 * dq + 4 * i);
        sq += (q[i][0] * q[i][0] + q[i][1] * q[i][1]) + (q[i][2] * q[i][2] + q[i][3] * q[i][3]); sk += (kn[i][0] * kn[i][0] + kn[i][1] * kn[i][1]) + (kn[i][2] * kn[i][2] + kn[i][3] * kn[i][3]); }
    sq += __shfl_xor(sq, 1); sq += __shfl_xor(sq, 2); sk += __shfl_xor(sk, 1); sk += __shfl_xor(sk, 2);
    const float rq = (1.0f / sqrtf(sq * (1.0f / 64.0f) + 1e-6f)) * QSCALE, rk = 1.0f / sqrtf(sk * (1.0f / 64.0f) + 1e-6f);
#pragma unroll
    for (int i = 0; i < 4; ++i) { q[i] = q[i] * rq * *(const f32x4*)(qg + 16 * dq + 4 * i); kn[i] = kn[i] * rk * *(const f32x4*)(kg + 16 * dq + 4 * i); }
    asm volatile("s_waitcnt vmcnt(0)" ::: "memory");
    if (g == 3 && kk == 0) {
#pragma unroll
        for (int i = 0; i < 4; ++i) { *(LAS f32x4*)(Kl + 127 * 256 + dq * 64 + i * 16) = kn[i]; *(LAS f32x4*)(Vl + 127 * 256 + dq * 64 + i * 16) = vn[i]; } }
    asm volatile("s_waitcnt lgkmcnt(0)\n\ts_barrier" ::: "memory");
    float sc[8];
#pragma unroll
    for (int ps = 0; ps < 8; ++ps) { const LAS unsigned char* kr = Kl + (16 * ps + kk) * 256 + dq * 64; float a = 0.f;
#pragma unroll
        for (int i = 0; i < 4; ++i) { const f32x4 kf = *(const LAS f32x4*)(kr + i * 16); a += (q[i][0] * kf[0] + q[i][1] * kf[1]) + (q[i][2] * kf[2] + q[i][3] * kf[3]); }
        a += __shfl_xor(a, 1); a += __shfl_xor(a, 2); sc[ps] = a; }
    const float sk2 = sink[h] * LOG2E;
    float mx = sk2;
#pragma unroll
    for (int ps = 0; ps < 8; ++ps) mx = fmaxf(mx, sc[ps]);
#pragma unroll
    for (int of = 4; of < 64; of <<= 1) mx = fmaxf(mx, __shfl_xor(mx, of));
    float ls = 0.f;
#pragma unroll
    for (int ps = 0; ps < 8; ++ps) { sc[ps] = __builtin_amdgcn_exp2f(sc[ps] - mx); ls += sc[ps]; }
#pragma unroll
    for (int of = 4; of < 64; of <<= 1) ls += __shfl_xor(ls, of);
    ls += __builtin_amdgcn_exp2f(sk2 - mx);
    f32x4 acc[4];
#pragma unroll
    for (int i = 0; i < 4; ++i) acc[i] = (f32x4){0.f, 0.f, 0.f, 0.f};
#pragma unroll
    for (int ps = 0; ps < 8; ++ps) { const LAS unsigned char* vr = Vl + (16 * ps + kk) * 256 + dq * 64;
#pragma unroll
        for (int i = 0; i < 4; ++i) acc[i] += *(const LAS f32x4*)(vr + i * 16) * sc[ps]; }
    const float inv = 1.0f / ls;
#pragma unroll
    for (int i = 0; i < 4; ++i)
#pragma unroll
        for (int e = 0; e < 4; ++e) { float v = acc[i][e]; v += __shfl_xor(v, 4); v += __shfl_xor(v, 8); v += __shfl_xor(v, 16); v += __shfl_xor(v, 32); acc[i][e] = v * inv; }
    if (kk == 0) {
#pragma unroll
        for (int i = 0; i < 4; ++i) { v2u w; w.x = pk2(acc[i][0], acc[i][1]); w.y = pk2(acc[i][2], acc[i][3]); *(v2u*)(o + (size_t)n * 1024 + h * 64 + 16 * dq + 4 * i) = w; }
    }
    if (g == 3 && kk == 0) { const size_t off = ((size_t)(n * 128 + 127) * 4 + kv) * 64 + 16 * dq;
#pragma unroll
        for (int i = 0; i < 4; ++i) { *(f32x4*)(kso + off + 4 * i) = kn[i]; *(f32x4*)(vso + off + 4 * i) = vn[i]; } }
    asm volatile("s_waitcnt lgkmcnt(0)\n\ts_barrier" ::: "memory");
}

__device__ __forceinline__ void ssm_step2(const int (&n)[2], const int (&g)[2], const ssm::Tab T, const float* __restrict__ x, const float* __restrict__ sss, const float* __restrict__ h0r, const float* __restrict__ h0i,
                                          bf16* __restrict__ z, float* __restrict__ out_re, float* __restrict__ out_im, LAS f32x2* xs, int lane) {
    const int c = lane & 15, pq = lane >> 4;
    float r[2], uc[2], dgc[2], nr[2], ni[2]; bf16x8 cr0[2], cr1[2], ci0[2], ci1[2];
#pragma unroll
    for (int k = 0; k < 2; ++k) {
        r[k] = rs_of(sss, n[k]);
        const float* xr = x + (size_t)n[k] * 1024 + g[k] * 16;
        float u[16];
#pragma unroll
        for (int i = 0; i < 4; ++i) { const f32x4 v = *(const f32x4*)(xr + 4 * i); u[4 * i] = v[0]; u[4 * i + 1] = v[1]; u[4 * i + 2] = v[2]; u[4 * i + 3] = v[3]; }
        const bf16x8* br = (const bf16x8*)(T.bbt + ((size_t)g[k] * 128 + lane) * 16); const bf16x8* bi = (const bf16x8*)(T.bbt + ((size_t)g[k] * 128 + 64 + lane) * 16);
        const bf16x8* cr = (const bf16x8*)(T.cct + ((size_t)g[k] * 16 + c) * 128 + 16 * pq); const bf16x8* ci = (const bf16x8*)(T.cct + ((size_t)g[k] * 16 + c) * 128 + 64 + 16 * pq);
        cr0[k] = cr[0]; cr1[k] = cr[1]; ci0[k] = ci[0]; ci1[k] = ci[1];
        uc[k] = xr[c]; dgc[k] = T.dg[g[k] * 16 + c];
        float bur = 0.f, bui = 0.f;
#pragma unroll
        for (int hh = 0; hh < 2; ++hh) { const bf16x8 a = br[hh], b = bi[hh];
#pragma unroll
            for (int e = 0; e < 8; ++e) { bur += u[8 * hh + e] * bf2f((unsigned short)a[e]); bui += u[8 * hh + e] * bf2f((unsigned short)b[e]); } }
        const f32x2 A = *(const f32x2*)(T.ab + 2 * (g[k] * 64 + lane));
        const size_t si = ((size_t)n[k] * 64 + g[k]) * 64 + lane;
        const float sr = h0r[si], sim = h0i[si];
        nr[k] = A.x * sr - A.y * sim + r[k] * bur; ni[k] = A.x * sim + A.y * sr + r[k] * bui;
        out_re[si] = nr[k]; out_im[si] = ni[k];
        xs[64 * k + lane] = f32x2{nr[k], ni[k]};
    }
    LDS_WAIT(); asm volatile("" ::: "memory");
#pragma unroll
    for (int k = 0; k < 2; ++k) {
        float y = 0.f;
#pragma unroll
        for (int q2 = 0; q2 < 8; ++q2) { const f32x4 q = *(const LAS f32x4*)(xs + 64 * k + 16 * pq + 2 * q2);
            const int e0 = 2 * q2, e1 = 2 * q2 + 1;
            const float c0r = bf2f((unsigned short)(e0 < 8 ? cr0[k][e0] : cr1[k][e0 - 8])), c0i = bf2f((unsigned short)(e0 < 8 ? ci0[k][e0] : ci1[k][e0 - 8]));
            const float c1r = bf2f((unsigned short)(e1 < 8 ? cr0[k][e1] : cr1[k][e1 - 8])), c1i = bf2f((unsigned short)(e1 < 8 ? ci0[k][e1] : ci1[k][e1 - 8]));
            y += q[0] * c0r + q[1] * c0i + q[2] * c1r + q[3] * c1i; }
        y += __shfl_xor(y, 16); y += __shfl_xor(y, 32);
        if (lane < 16) {
            const float yy = y + dgc[k] * r[k] * uc[k];
            const float u2 = 1.5957691216057308f * (yy + 0.044715f * yy * yy * yy);
            z[(size_t)n[k] * 1024 + g[k] * 16 + lane] = (bf16)f2bf(yy * __builtin_amdgcn_rcpf(1.0f + __builtin_amdgcn_exp2f(-LOG2E * u2)));
        }
    }
    LDS_WAIT(); asm volatile("" ::: "memory");
}
}
#define XB_TMO      128
#define XB_XCNT(j)  (256  + 64 * (j))
#define XB_XSUB(j)  (1280 + 64 * (j))
#define XB_XGEN(j)  (2304 + 64 * (j))
#define XB_TOP      3328
#define XB_TOPGEN   3392
#define XCD_BAR_WORDS 3456
#define XB_SPIN_CAP (1u << 18)

__device__ __forceinline__ unsigned xb_ld(unsigned* p)              { return __hip_atomic_load(p, __ATOMIC_RELAXED, __HIP_MEMORY_SCOPE_AGENT); }
__device__ __forceinline__ unsigned xb_add(unsigned* p, unsigned v) { return __hip_atomic_fetch_add(p, v, __ATOMIC_RELAXED, __HIP_MEMORY_SCOPE_AGENT); }
__device__ __forceinline__ unsigned xb_xcc_id() { return (unsigned)__builtin_amdgcn_s_getreg((3 << 11) | 20) & 0xFu; }
#define XB_SPIN(cond, bar) do { unsigned _sp = 0; while (cond) { __builtin_amdgcn_s_sleep(1); \
    if ((++_sp & 255u) == 0u) { if (xb_ld(&(bar)[XB_TMO])) break; if (_sp > XB_SPIN_CAP) { atomicAdd(&(bar)[XB_TMO], 1u); break; } } } } while (0)

struct XcdBarrier {
    unsigned* bar; unsigned x;
    volatile LAS unsigned* st;
};

__device__ __forceinline__ XcdBarrier xcd_barrier_post(unsigned* bar, volatile LAS unsigned* st) {
    XcdBarrier b; b.bar = bar; b.x = xb_xcc_id(); b.st = st;
    if (threadIdx.x == 0) (void)xb_add(&bar[XB_XCNT(b.x)], 1u);
    return b;
}
__device__ __forceinline__ void xcd_barrier_complete(unsigned* bar, unsigned x, unsigned& nloc, unsigned& nx) {
    const unsigned G = gridDim.x * gridDim.y * gridDim.z;
    unsigned sum, cnt, mine, sp = 0u;
    for (;;) {
        sum = 0u; cnt = 0u; mine = 0u;
#pragma unroll
        for (unsigned j = 0; j < 16; ++j) { const unsigned c = xb_ld(&bar[XB_XCNT(j)]); sum += c; cnt += (c > 0u) ? 1u : 0u; mine = (j == x) ? c : mine; }
        if (sum == G) break;
        __builtin_amdgcn_s_sleep(1);
        if ((++sp & 255u) == 0u) { if (xb_ld(&bar[XB_TMO])) break; if (sp > XB_SPIN_CAP) { atomicAdd(&bar[XB_TMO], 1u); break; } }
    }
    nloc = mine > 0u ? mine : 1u; nx = cnt > 0u ? cnt : 1u;
}

__device__ __forceinline__ void xcd_barrier(const XcdBarrier& b) {
    asm volatile("s_waitcnt vmcnt(0)" ::: "memory");
    __syncthreads();
    if (threadIdx.x == 0) {
        unsigned* bar = b.bar;
        __builtin_amdgcn_s_waitcnt(0);
        unsigned nloc = b.st[0], nx = b.st[1];
        if (nloc == 0u) { xcd_barrier_complete(bar, b.x, nloc, nx); b.st[0] = nloc; b.st[1] = nx; }
        const unsigned old = xb_add(&bar[XB_XSUB(b.x)], 1u);
        const unsigned gen = old / nloc;
        if (old + 1u == (gen + 1u) * nloc) {
            __builtin_amdgcn_fence(__ATOMIC_RELEASE, "agent");
            asm volatile("s_waitcnt vmcnt(0)" ::: "memory");
            const unsigned og = xb_add(&bar[XB_TOP], 1u);
            const unsigned tg = og / nx;
            if (og + 1u == (tg + 1u) * nx) xb_add(&bar[XB_TOPGEN], 1u);
            else XB_SPIN(xb_ld(&bar[XB_TOPGEN]) == tg, bar);
            __builtin_amdgcn_fence(__ATOMIC_ACQUIRE, "agent");
            xb_add(&bar[XB_XGEN(b.x)], 1u);
            asm volatile("s_waitcnt vmcnt(0)" ::: "memory");
        } else {
            XB_SPIN(xb_ld(&bar[XB_XGEN(b.x)]) == gen, bar);
            __builtin_amdgcn_fence(__ATOMIC_ACQUIRE, "agent");
            asm volatile("s_waitcnt vmcnt(0)" ::: "memory");
        }
    }
    __syncthreads();
}


constexpr int NWAVES = 8;
constexpr int RING_BYTES = 131072;
constexpr int LDS_BYTES = 163840;
constexpr int LDSCTL_OFF = LDS_BYTES - 1024, MISC_OFF = LDSCTL_OFF + 320;
static_assert(8 * ssm::WREG <= LDSCTL_OFF && RING_BYTES <= LDSCTL_OFF, "LDS map");
enum Kind { K_PRO = 0, K_QKV, K_ATT, K_WO, K_S1, K_S2, K_S3, K_GLU, K_UP, K_DN };
constexpr int N_PHASES = 23;
__host__ __device__ __forceinline__ void phase_decode(int ph, int& layer, int& kind) {
    if (ph == 0) { layer = 0; kind = K_PRO; return; }
    const int q = ph - 1, pair = q / 11, r = q % 11;
    if (r < 5) { layer = 2 * pair; kind = r == 0 ? K_QKV : r == 1 ? K_ATT : r == 2 ? K_WO : r == 3 ? K_UP : K_DN; }
    else { layer = 2 * pair + 1; const int s = r - 5; kind = s == 0 ? K_S1 : s == 1 ? K_S2 : s == 2 ? K_S3 : s == 3 ? K_GLU : s == 4 ? K_UP : K_DN; }
}

struct Args {
    const float* in[27]; float* out; unsigned char* ws; int ph_lo, ph_hi, li, pad;
};

struct RM_ID  { __device__ __forceinline__ int operator()(int n) const { return n; } };
struct RM_QKV { __device__ __forceinline__ int operator()(int n) const { const int pn = n >> 8, l = n & 255, wc = l >> 6, d = l & 63, bj = d >> 5, fq = (d >> 3) & 3, nn = (d >> 2) & 1, e = d & 3; return (pn << 8) + 128 * bj + 32 * wc + 16 * nn + 4 * fq + e; } };
struct RM_GLU { __device__ __forceinline__ int operator()(int n) const { const int half = n >> 10, c = n & 1023, l = c & 127, wc = l >> 5, fq = (l >> 3) & 3, nn = (l >> 2) & 1, e = l & 3; return ((c >> 7) << 8) + 128 * half + 32 * wc + 16 * nn + 4 * fq + e; } };
struct RM_RES { __device__ __forceinline__ int operator()(int n) const { const int l = n & 31, fq = (l >> 3) & 3, nn = (l >> 2) & 1, e = l & 3; return (n & ~31) + 16 * nn + 4 * fq + e; } };
struct RM_UP  { __device__ __forceinline__ int operator()(int n) const { const int half = n >= 2816 ? 1 : 0, j = n - 2816 * half, pn = j >> 7, l = j & 127, wc = l >> 5, fq = (l >> 3) & 3, nn = (l >> 2) & 1, e = l & 3; return (pn << 8) + 128 * half + 32 * wc + 16 * nn + 4 * fq + e; } };

template <class RM>
__device__ __forceinline__ void transpose_item(const float* __restrict__ W, int K, int N, bf16* __restrict__ WT, const float* __restrict__ gain, LAS float* scr, int item, int lane, RM rm) {
    const int nblk = N / 32, kb = item / nblk, nb = item % nblk, k0 = 64 * kb, n0 = 32 * nb;
    const int kr = lane >> 3, n4 = (lane & 7) * 4;
    f32x4 v[8];
#pragma unroll
    for (int i = 0; i < 8; ++i) v[i] = *(const f32x4*)(W + (size_t)(k0 + 8 * i + kr) * N + n0 + n4);
#pragma unroll
    for (int i = 0; i < 8; ++i) { const float gk = gain ? gain[k0 + 8 * i + kr] : 1.0f; *(LAS f32x4*)(scr + (8 * i + kr) * 36 + n4) = v[i] * gk; }
    LDS_WAIT(); asm volatile("" ::: "memory");
    const int c = lane & 7;
#pragma unroll
    for (int j = 0; j < 4; ++j) { const int n = (lane >> 3) + 8 * j; const LAS float* s = scr + (8 * c) * 36 + n;
        v4u o; o.x = pk2(s[0 * 36], s[1 * 36]); o.y = pk2(s[2 * 36], s[3 * 36]); o.z = pk2(s[4 * 36], s[5 * 36]); o.w = pk2(s[6 * 36], s[7 * 36]);
        *(GAS v4u*)(WT + (size_t)rm(n0 + n) * K + k0 + 8 * c) = o; }
    LDS_WAIT(); asm volatile("" ::: "memory");
}
__device__ __forceinline__ void x_row_init(const float* __restrict__ src, float* xdst, bf16* __restrict__ xb, float* __restrict__ ssr, int nslots, int lane) {
    const GAS f32x4* xr = (const GAS f32x4*)src + lane; f32x4 v[4]; float s = 0.f;
#pragma unroll
    for (int j = 0; j < 4; ++j) { v[j] = xr[64 * j]; s += (v[j].x * v[j].x + v[j].y * v[j].y) + (v[j].z * v[j].z + v[j].w * v[j].w); }
    s = wave_sum(s);
#pragma unroll
    for (int j = 0; j < 4; ++j) { if (xdst) ((GAS f32x4*)xdst + lane)[64 * j] = v[j]; ((GAS unsigned long long*)xb + lane)[64 * j] = (unsigned long long)pk2(v[j].x, v[j].y) | ((unsigned long long)pk2(v[j].z, v[j].w) << 32); }
    if (lane < nslots) ssr[lane] = lane == 0 ? s : 0.f;
}

__device__ __forceinline__ void x_rows2_init(const float* __restrict__ s0, const float* __restrict__ s1, bf16* __restrict__ b0, bf16* __restrict__ b1, float* __restrict__ q0, float* __restrict__ q1, int lane) {
    const GAS f32x4* x0 = (const GAS f32x4*)s0 + lane; const GAS f32x4* x1 = (const GAS f32x4*)s1 + lane; f32x4 v[4], w[4]; float sa = 0.f, sb = 0.f;
#pragma unroll
    for (int j = 0; j < 4; ++j) { v[j] = x0[64 * j]; w[j] = x1[64 * j]; }
#pragma unroll
    for (int j = 0; j < 4; ++j) { sa += (v[j].x * v[j].x + v[j].y * v[j].y) + (v[j].z * v[j].z + v[j].w * v[j].w); sb += (w[j].x * w[j].x + w[j].y * w[j].y) + (w[j].z * w[j].z + w[j].w * w[j].w); }
    sa = wave_sum(sa); sb = wave_sum(sb);
#pragma unroll
    for (int j = 0; j < 4; ++j) { ((GAS unsigned long long*)b0 + lane)[64 * j] = (unsigned long long)pk2(v[j].x, v[j].y) | ((unsigned long long)pk2(v[j].z, v[j].w) << 32);
                                  ((GAS unsigned long long*)b1 + lane)[64 * j] = (unsigned long long)pk2(w[j].x, w[j].y) | ((unsigned long long)pk2(w[j].z, w[j].w) << 32); }
    if (lane < 16) { q0[lane] = lane == 0 ? sa : 0.f; q1[lane] = lane == 0 ? sb : 0.f; }
}

__device__ __forceinline__ void ffn_fixup(int pm, bool write_conv, const float* __restrict__ halo, const float* __restrict__ cw, const float* __restrict__ cb, bf16* __restrict__ act, float* __restrict__ conv_out) {
    const int tid = opaque_tid();
    for (int j = 4 * tid; j < 2816; j += 4 * 512) {
        f32x4 w0[2], w1[2], w2[2], bb[2];
#pragma unroll
        for (int hf = 0; hf < 2; ++hf) { const int c = j + 2816 * hf; w0[hf] = *(const f32x4*)(cw + c); w1[hf] = *(const f32x4*)(cw + 5632 + c); w2[hf] = *(const f32x4*)(cw + 2 * 5632 + c); bb[hf] = *(const f32x4*)(cb + c); }
        f32x4 H0[2][2], H1[2][2], P2[2][2], P3[2][2];
#pragma unroll
        for (int b = 0; b < 2; ++b) {
            const int blk = 2 * pm + b; const bool first = (blk & 31) == 0;
            const float* h0 = halo + (size_t)blk * 4 * 5632; const float* hp = halo + (size_t)(first ? blk : blk - 1) * 4 * 5632;
#pragma unroll
            for (int hf = 0; hf < 2; ++hf) { const int c = j + 2816 * hf; H0[b][hf] = *(const f32x4*)(h0 + c); H1[b][hf] = *(const f32x4*)(h0 + 5632 + c);
                P2[b][hf] = *(const f32x4*)(hp + 2 * 5632 + c); P3[b][hf] = *(const f32x4*)(hp + 3 * 5632 + c);
                if (first) { P2[b][hf] = (f32x4){0.f, 0.f, 0.f, 0.f}; P3[b][hf] = (f32x4){0.f, 0.f, 0.f, 0.f}; } }
        }
#pragma unroll
        for (int b = 0; b < 2; ++b) {
            const int blk = 2 * pm + b;
            const f32x4 g0 = bb[0] + w2[0] * H0[b][0] + w1[0] * P3[b][0] + w0[0] * P2[b][0], v0 = bb[1] + w2[1] * H0[b][1] + w1[1] * P3[b][1] + w0[1] * P2[b][1];
            const f32x4 g1 = bb[0] + w2[0] * H1[b][0] + w1[0] * H0[b][0] + w0[0] * P3[b][0], v1 = bb[1] + w2[1] * H1[b][1] + w1[1] * H0[b][1] + w0[1] * P3[b][1];
            f32x4 o0, o1;
#pragma unroll
            for (int e = 0; e < 4; ++e) { o0[e] = g0[e] * __builtin_amdgcn_rcpf(1.0f + __builtin_amdgcn_exp2f(-LOG2E * g0[e])) * v0[e]; o1[e] = g1[e] * __builtin_amdgcn_rcpf(1.0f + __builtin_amdgcn_exp2f(-LOG2E * g1[e])) * v1[e]; }
            v2u q0, q1; q0.x = pk2(o0[0], o0[1]); q0.y = pk2(o0[2], o0[3]); q1.x = pk2(o1[0], o1[1]); q1.y = pk2(o1[2], o1[3]);
            *(v2u*)(act + (size_t)(128 * blk) * 2816 + j) = q0; *(v2u*)(act + (size_t)(128 * blk + 1) * 2816 + j) = q1;
        }
    }
    if (write_conv && (pm & 15) == 15) {
        const int blk = 2 * pm + 1, n = pm >> 4; const float* h0 = halo + (size_t)blk * 4 * 5632;
        for (int c = 4 * tid; c < 2 * 5632; c += 4 * 512) *(f32x4*)(conv_out + (size_t)n * 2 * 5632 + c) = *(const f32x4*)(h0 + 2 * 5632 + c);
    }
}

constexpr int XL_RS = RING_BYTES, XL_CV = RING_BYTES + 6 * 1024;
static_assert(XL_CV + 6 * 4096 <= LDSCTL_OFF, "spare LDS");
template <bool APERM_UNUSED, bool CONV>
__device__ __forceinline__ void prestage(LAS unsigned char* L, const pg8::StaticOrder& S, const float* __restrict__ ss, int np4, const float* __restrict__ cw, const float* __restrict__ cb) {
    const int tid = opaque_tid(), l8 = tid & 7;
    pg8::Unit u[6]; bool ok[6];
#pragma unroll
    for (int i = 0; i < 6; ++i) ok[i] = S.next(i, u[i]);
    f32x4 rt[6][4], tv[6];
#pragma unroll
    for (int i = 0; i < 6; ++i) {
#pragma unroll
        for (int k = 0; k < 4; ++k) rt[i][k] = (f32x4){0.f, 0.f, 0.f, 0.f};
        tv[i] = (f32x4){0.f, 0.f, 0.f, 0.f};
        if (ok[i]) {
            if (l8 < np4) {
#pragma unroll
                for (int k = 0; k < 4; ++k) rt[i][k] = *(const f32x4*)(ss + (size_t)(u[i].pm * 256 + 64 * k + (tid >> 3)) * 32 + 4 * l8); }
            if (CONV && tid < 256) { const int a = tid >> 5, j = u[i].pn * 128 + 4 * (tid & 31);
                const float* src = (a & 3) == 3 ? cb + j : cw + (size_t)(a & 3) * 5632 + j;
                tv[i] = *(const f32x4*)(src + (a >> 2) * 2816); }
        }
    }
#pragma unroll
    for (int i = 0; i < 6; ++i) if (ok[i]) {
#pragma unroll
        for (int k = 0; k < 4; ++k) { const int row = 64 * k + (tid >> 3);
            float sm = (rt[i][k][0] + rt[i][k][1]) + (rt[i][k][2] + rt[i][k][3]);
            sm += __shfl_xor(sm, 1); sm += __shfl_xor(sm, 2); sm += __shfl_xor(sm, 4);
            if (l8 == 0) ((LAS float*)(L + XL_RS))[i * 256 + row] = __builtin_amdgcn_rsqf(sm * (1.0f / 1024.0f) + 1e-6f); }
        if (CONV && tid < 256) { const int a = tid >> 5; *(LAS f32x4*)(L + XL_CV + i * 4096 + a * 512 + (tid & 31) * 16) = tv[i] * (a < 4 ? -LOG2E : -0.6931471805599453f); }
    }
    __syncthreads();
}

__device__ __forceinline__ void convert_layer(const Args& args, unsigned char* ws, int layer, int gw, int ngw, LAS float* scr, int lane) {
    constexpr int I_QKV = 16 * 48, I_WO = 16 * 32, I_GLU = 16 * 64, I_UP = 16 * 176, I_DN = 44 * 32;
    const int jm = layer >> 1; const bool swa = (layer & 1) == 0;
    const int n_mix = swa ? I_QKV + I_WO : I_GLU, n_all = n_mix + I_UP + I_DN;
    for (int it = gw; it < n_all; it += ngw) {
        int r = it;
        if (r < n_mix) {
            if (swa) { if (r < I_QKV) transpose_item(args.in[9] + (size_t)jm * 1024 * 1536, 1024, 1536, (bf16*)(ws + WS_WQKV) + (size_t)jm * 1536 * 1024, args.in[7] + (size_t)layer * 1024, scr, r, lane, RM_QKV());
                       else transpose_item(args.in[10] + (size_t)jm * 1024 * 1024, 1024, 1024, (bf16*)(ws + WS_WO) + (size_t)jm * 1024 * 1024, nullptr, scr, r - I_QKV, lane, RM_RES()); }
            else transpose_item(args.in[22] + (size_t)jm * 1024 * 2048, 1024, 2048, (bf16*)(ws + WS_WGLU) + (size_t)jm * 2048 * 1024, nullptr, scr, r, lane, RM_GLU());
            continue; }
        r -= n_mix;
        if (r < I_UP) { transpose_item(args.in[23] + (size_t)layer * 1024 * 5632, 1024, 5632, (bf16*)(ws + WS_WUP) + (size_t)layer * 5632 * 1024, args.in[8] + (size_t)layer * 1024, scr, r, lane, RM_UP()); continue; }
        r -= I_UP;
        transpose_item(args.in[26] + (size_t)layer * 2816 * 1024, 2816, 1024, (bf16*)(ws + WS_WDN) + (size_t)layer * 1024 * 2816, nullptr, scr, r, lane, RM_RES());
    }
}

#ifndef ONLY_KIND
#define ONLY_KIND -1
#endif
#define EN(k) (ONLY_KIND < 0 || ONLY_KIND == (k))
#ifndef SAMPLE
#define SAMPLE 1
#endif
__global__ void __launch_bounds__(NWAVES * 64, 2) mega_fwd(Args args) {
    extern __shared__ __attribute__((aligned(16))) unsigned char lds[];
    LAS unsigned char* L = (LAS unsigned char*)lds;
    volatile LAS unsigned* MISC = (volatile LAS unsigned*)(L + MISC_OFF);
    constexpr int G = 256;
    if (gridDim.x != G) __builtin_trap();
    const int bx = blockIdx.x; const int vcu = (G % 8 == 0) ? (bx % 8) * (G / 8) + bx / 8 : bx;
    unsigned char* ws = args.ws;
    gu32* ctl = (gu32*)(ws + WS_CTL);
    float* out = args.out; float* x = out;
    bf16* XB = (bf16*)(ws + WS_XB); float* SS = (float*)(ws + WS_SS);
    bf16* Qb = (bf16*)(ws + WS_Q); bf16* Kb = (bf16*)(ws + WS_K); bf16* Vb = (bf16*)(ws + WS_V); bf16* Ob = (bf16*)(ws + WS_O);
    bf16* ACT = (bf16*)(ws + WS_ACT); float* HALO = (float*)(ws + WS_HALO);
    float* SSS = (float*)(ws + sg::WS_SSS); float* QKVS = (float*)(ws + sg::WS_QKVS);
    for (int u = threadIdx.x; u < (LDS_BYTES - LDSCTL_OFF) / 4; u += NWAVES * 64) ((LAS unsigned*)(L + LDSCTL_OFF))[u] = 0u;
    __syncthreads();
    XcdBarrier bar = xcd_barrier_post((unsigned*)(ctl + CW_BAR) + args.li * XCD_BAR_WORDS, MISC + 8);

    for (int ph = args.ph_lo; ph < args.ph_hi; ++ph) {
        int layer, kind; phase_decode(ph, layer, kind);
        const int tid = opaque_tid(), lane = tid & 63, wave = __builtin_amdgcn_readfirstlane(tid >> 6);
        const int jm = layer >> 1;
        const sg::P sp{x + (size_t)MP * 1024, XB + (size_t)MP * 1024, SSS, QKVS, ACT + (size_t)MP * 2816, args.in[24] + (size_t)layer * 3 * 5632, args.in[25] + (size_t)layer * 5632,
                       args.in[6] + (size_t)layer * DB * 2 * 5632, out + O_CS + (size_t)layer * DB * 2 * 5632};
        const int gwv = vcu * NWAVES + wave;
        if (kind == K_PRO && EN(K_PRO)) {
            LAS float* scr = (LAS float*)(L + wave * 16384);
            const int gw = vcu * NWAVES + wave, NGW = G * NWAVES;
            convert_layer(args, ws, 0, gw, NGW, scr, lane);
            if ((gw & 15) == 0 || G != 256) for (int t = (G == 256 ? (gw >> 4) : gw) * 64 + lane; t < 8192; t += (G == 256 ? NGW / 16 : NGW) * 64) { const int j = t >> 12, gp = t & 4095;
                ssm::build_tables(ws, j, gp, args.in[14] + (size_t)j * 4096, args.in[15] + (size_t)j * 4096, args.in[16] + j * 64, args.in[17] + (size_t)j * 65536, args.in[18] + (size_t)j * 65536,
                                  args.in[19] + (size_t)j * 65536, args.in[20] + (size_t)j * 65536, args.in[21] + (size_t)j * 1024, args.in[7] + (size_t)(2 * j + 1) * 1024); }
            for (int m = gw; m + NGW < MP; m += 2 * NGW) x_rows2_init(args.in[0] + (size_t)m * 1024, args.in[0] + (size_t)(m + NGW) * 1024, XB + (size_t)m * 1024, XB + (size_t)(m + NGW) * 1024, SS + (size_t)m * 32, SS + (size_t)(m + NGW) * 32, lane);
            for (int m = gw; m < DB; m += NGW) x_row_init(args.in[1] + (size_t)m * 1024, x + (size_t)(MP + m) * 1024, XB + (size_t)(MP + m) * 1024, SSS + (size_t)m * 64, 64, lane);
        } else if (kind == K_QKV && EN(K_QKV)) {
            if (SAMPLE) for (int u = G - 1 - bx; u < 96; u += G) sg::unit<sg::M_QKV, 1024, 8>(u, XB + (size_t)MP * 1024, (const bf16*)(ws + WS_WQKV) + (size_t)jm * 1536 * 1024, sp, L);
            pg8::Gemm g{XB, (const bf16*)(ws + WS_WQKV) + (size_t)jm * 1536 * 1024, MP, 1536, 1024}; pg8::StaticOrder S; S.init(MP, 1536, G, bx);
            if (tid < 128) ((LAS float*)(L + XL_CV))[tid] = tid < 64 ? args.in[11][jm * 64 + tid] : args.in[12][jm * 64 + tid - 64];
            prestage<false, false>(L, S, SS, 4, nullptr, nullptr);
            pg8::EpiQKV E{Qb, Kb, Vb, (LAS const float*)(L + XL_RS), (LAS const float*)(L + XL_CV), (LAS const float*)(L + XL_CV) + 64, out + O_KP + (size_t)jm * NB * WIN * 256, out + O_VP + (size_t)jm * NB * WIN * 256};
            pg8::gemm_phase<pg8::EpiQKV, pg8::StaticOrder, true, true, false>(L, g, S, E);
            if (G == 256 && bx >= 128) convert_layer(args, ws, layer + 1, (bx - 128) * NWAVES + wave, 128 * NWAVES, (LAS float*)(L + wave * 16384), lane);
        } else if (kind == K_ATT && EN(K_ATT)) {
            if (!(bx & 1)) {
            if (SAMPLE) for (int pid0 = 2 * vcu; pid0 < 512; pid0 += 2 * G) sg::attn_pairs(pid0, QKVS, args.in[2] + (size_t)jm * DB * WIN * 256, args.in[3] + (size_t)jm * DB * WIN * 256, args.in[11] + jm * 64, args.in[12] + jm * 64,
                                                                                   args.in[13] + jm * 16, Ob + (size_t)MP * 1024, out + O_KS + (size_t)jm * DB * WIN * 256, out + O_VS + (size_t)jm * DB * WIN * 256, L);
            }
            { const att::Roll rl{(const f32x4*)(args.in[2] + (size_t)jm * DB * WIN * 256), (const f32x4*)(args.in[3] + (size_t)jm * DB * WIN * 256), (f32x4*)(out + O_KS + (size_t)jm * DB * WIN * 256), (f32x4*)(out + O_VS + (size_t)jm * DB * WIN * 256)};
              { const int id = vcu * 4; if (id < 1024) att::attn_units4(id >> 8, id & 63, (id >> 6) & 3, Qb, Kb, Vb, Ob, args.in[13] + jm * 16, (LAS char*)L, rl, SAMPLE ? id : -1); } }
            if (bx & 1) {
            if (SAMPLE) for (int pid0 = 2 * vcu; pid0 < 512; pid0 += 2 * G) sg::attn_pairs(pid0, QKVS, args.in[2] + (size_t)jm * DB * WIN * 256, args.in[3] + (size_t)jm * DB * WIN * 256, args.in[11] + jm * 64, args.in[12] + jm * 64,
                                                                                   args.in[13] + jm * 16, Ob + (size_t)MP * 1024, out + O_KS + (size_t)jm * DB * WIN * 256, out + O_VS + (size_t)jm * DB * WIN * 256, L);
            }
        } else if (kind == K_WO && EN(K_WO)) {
            if (SAMPLE) for (int u = G - 1 - bx; u < 256; u += G) sg::unit<sg::M_RES, 1024, 2>(u, Ob + (size_t)MP * 1024, (const bf16*)(ws + WS_WO) + (size_t)jm * 1024 * 1024, sp, L);
            pg8::Gemm g{Ob, (const bf16*)(ws + WS_WO) + (size_t)jm * 1024 * 1024, MP, 1024, 1024}; pg8::StaticOrder S; S.init(MP, 1024, G, bx);
            pg8::EpiRes E{nullptr, XB, SS};
            pg8::gemm_phase<pg8::EpiRes, pg8::StaticOrder, true, true, false>(L, g, S, E);
        } else if (kind == K_S1 && EN(K_S1)) {
            if (SAMPLE) for (int pr = gwv; pr < 4096; pr += G * NWAVES) { const int nn[2] = {pr >> 6, (pr + 4096) >> 6}, gg[2] = {pr & 63, pr & 63};
                sg::ssm_step2(nn, gg, ssm::tab_of(ws, jm), x + (size_t)MP * 1024, SSS, args.in[4] + (size_t)jm * DB * 4096, args.in[5] + (size_t)jm * DB * 4096,
                              Ob + (size_t)MP * 1024, out + O_SRS + (size_t)jm * DB * 4096, out + O_SIS + (size_t)jm * DB * 4096, (LAS f32x2*)(L + wave * ssm::WREG), lane); }
            for (int id = vcu; id < 256; id += G) ssm::unit<false>(id >> 6, id & 63, ssm::tab_of(ws, jm), XB, SS, (f32x2*)(ws + WS_SSM + 2 * MiB), Ob, L);
        } else if (kind == K_S2 && EN(K_S2)) {
            ssm::carries(vcu, G, ssm::tab_of(ws, jm), (const f32x2*)(ws + WS_SSM + 2 * MiB), (f32x2*)(ws + WS_SSM + 18 * MiB), out + O_SRP + (size_t)jm * NB * 4096, out + O_SIP + (size_t)jm * NB * 4096);
            if (layer + 1 < DEPTH) convert_layer(args, ws, layer + 1, vcu * NWAVES + wave, G * NWAVES, (LAS float*)(L + wave * 16384), lane);
        } else if (kind == K_S3 && EN(K_S3)) {
            for (int id = vcu; id < 256; id += G) ssm::unit<true>(id >> 6, id & 63, ssm::tab_of(ws, jm), XB, SS, (f32x2*)(ws + WS_SSM + 18 * MiB), Ob, L);
        } else if (kind == K_GLU && EN(K_GLU)) {
            if (SAMPLE) for (int u = G - 1 - bx; u < 256; u += G) sg::unit<sg::M_GLU, 1024, 2>(u, Ob + (size_t)MP * 1024, (const bf16*)(ws + WS_WGLU) + (size_t)jm * 2048 * 1024, sp, L);
            pg8::Gemm g{Ob, (const bf16*)(ws + WS_WGLU) + (size_t)jm * 2048 * 1024, MP, 2048, 1024}; pg8::StaticOrder S; S.init(MP, 2048, G, bx);
            pg8::EpiGlu E{XB, SS};
            pg8::gemm_phase<pg8::EpiGlu, pg8::StaticOrder, true, true, false>(L, g, S, E);
        } else if (kind == K_UP && EN(K_UP)) {
            if (SAMPLE) {
                const bool slack = G == 256;
                for (int k = 0; k < 3; ++k) { const int u = slack ? (bx >= 128 ? (bx - 128) + 128 * k : 352) : (k < 2 ? (G - 1 - bx) + 256 * k : 352);
                    if (u < 352) sg::unit<sg::M_UP, 1024, 4>(u, XB + (size_t)MP * 1024, (const bf16*)(ws + WS_WUP) + (size_t)layer * 5632 * 1024, sp, L); }
            }
            pg8::Gemm g{XB, (const bf16*)(ws + WS_WUP) + (size_t)layer * 5632 * 1024, MP, 5632, 1024}; pg8::StaticOrder S; S.init(MP, 5632, G, bx);
            prestage<true, true>(L, S, SS, (layer & 1) ? 8 : 4, args.in[24] + (size_t)layer * 3 * 5632, args.in[25] + (size_t)layer * 5632);
            pg8::EpiUp E{ACT, HALO, (LAS const float*)(L + XL_RS), (LAS const float*)(L + XL_CV)};
            pg8::gemm_phase<pg8::EpiUp, pg8::StaticOrder, true, true, true>(L, g, S, E);
        } else if (kind == K_DN && EN(K_DN)) {
            pg8::Gemm g{ACT, (const bf16*)(ws + WS_WDN) + (size_t)layer * 1024 * 2816, MP, 1024, 2816}; pg8::StaticOrder S; S.init(MP, 1024, G, bx);
            { pg8::Unit u0; for (int i = 0; S.next(i, u0); ++i) ffn_fixup(u0.pm, u0.pn == 0, HALO, args.in[24] + (size_t)layer * 3 * 5632, args.in[25] + (size_t)layer * 5632, ACT, out + O_CP + (size_t)layer * NB * 2 * 5632); }
            if (SAMPLE) for (int u = G - 1 - bx; u < 256; u += G) sg::unit<sg::M_RES, 2816, 2>(u, ACT + (size_t)MP * 2816, (const bf16*)(ws + WS_WDN) + (size_t)layer * 1024 * 2816, sp, L);
            __builtin_amdgcn_s_waitcnt(0x0F70); VM_WAIT(); __syncthreads();
            __builtin_amdgcn_s_waitcnt(0x0F70);
            pg8::EpiRes E{layer == DEPTH - 1 ? x : nullptr, XB, SS};
            pg8::gemm_phase<pg8::EpiRes, pg8::StaticOrder, true, true, false>(L, g, S, E);
        }
        if (ph + 1 < args.ph_hi) xcd_barrier(bar);
    }
}
extern "C" void kernel_launch(void* const* d_in, const int* in_sizes, int n_in, void* d_out, int out_size, void* d_ws, size_t ws_size, hipStream_t stream) {
    static int grid = 0;
    if (grid == 0) {
        if (n_in != 27 || ws_size < WS_END || (size_t)out_size != O_END) { fprintf(stderr, "kernel_launch: unexpected sizes: n_in %d ws %zu out %d\n", n_in, ws_size, out_size); grid = -1; return; }
        int dev = 0, cus = 0, per_cu = 0;
        if (hipGetDevice(&dev) != hipSuccess || hipDeviceGetAttribute(&cus, hipDeviceAttributeMultiprocessorCount, dev) != hipSuccess) { grid = -1; return; }
        if (hipFuncSetAttribute((const void*)mega_fwd, hipFuncAttributeMaxDynamicSharedMemorySize, LDS_BYTES) != hipSuccess) { fprintf(stderr, "kernel_launch: hipFuncSetAttribute failed\n"); grid = -1; return; }
        if (hipOccupancyMaxActiveBlocksPerMultiprocessor(&per_cu, (const void*)mega_fwd, NWAVES * 64, LDS_BYTES) != hipSuccess || per_cu < 1) { fprintf(stderr, "kernel_launch: occupancy query says %d blocks per CU\n", per_cu); grid = -1; (void)hipGetLastError(); return; }
        (void)hipGetLastError();
        if (cus < 256) { fprintf(stderr, "kernel_launch: %d CUs; this kernel's phase programs are laid out for 256 co-resident workgroups\n", cus); grid = -1; return; }
        grid = 256;
    }
    if (grid < 0) return;
    (void)hipMemsetAsync((unsigned char*)d_ws + WS_CTL, 0, CTL_ZERO_BYTES, stream);
    Args a{}; for (int i = 0; i < 27; ++i) a.in[i] = (const float*)d_in[i];
    a.out = (float*)d_out; a.ws = (unsigned char*)d_ws; a.ph_lo = 0; a.ph_hi = N_PHASES; a.li = 0;
    hipLaunchKernelGGL(mega_fwd, dim3(grid), dim3(NWAVES * 64), LDS_BYTES, stream, a);
}
```

```cpp
#include <hip/hip_runtime.h>
#include <cstdio>
#include <cstdint>
#include <cmath>

constexpr int D = 1024, NB = 4, SEQ = 4096, DEPTH = 4, DB = 128;
constexpr int MP = NB * SEQ;
constexpr int MT = MP + DB;
constexpr int NH = 16, NKV = 4, HD = 64, WIN = 128;
constexpr int NQKV = (NH + 2 * NKV) * HD;
constexpr int NG = 64, SG = 16, NS = 64;
constexpr int FF = 2816, F2 = 2 * FF;
constexpr float EPS = 1e-6f;

constexpr size_t O_Y = 0;
constexpr size_t O_YS = O_Y + (size_t)MP * D;
constexpr size_t O_KP = O_YS + (size_t)DB * D;
constexpr size_t O_VP = O_KP + (size_t)2 * NB * WIN * NKV * HD;
constexpr size_t O_KS = O_VP + (size_t)2 * NB * WIN * NKV * HD;
constexpr size_t O_VS = O_KS + (size_t)2 * DB * WIN * NKV * HD;
constexpr size_t O_SRP = O_VS + (size_t)2 * DB * WIN * NKV * HD;
constexpr size_t O_SIP = O_SRP + (size_t)2 * NB * NG * NS;
constexpr size_t O_SRS = O_SIP + (size_t)2 * NB * NG * NS;
constexpr size_t O_SIS = O_SRS + (size_t)2 * DB * NG * NS;
constexpr size_t O_CP = O_SIS + (size_t)2 * DB * NG * NS;
constexpr size_t O_CS = O_CP + (size_t)DEPTH * NB * 2 * F2;
constexpr size_t O_END = O_CS + (size_t)DEPTH * DB * 2 * F2;

#define GAS __attribute__((address_space(1)))
#define LAS __attribute__((address_space(3)))
typedef unsigned short bf16;
typedef unsigned v4u __attribute__((ext_vector_type(4)));
typedef unsigned v2u __attribute__((ext_vector_type(2)));
typedef float f32x4 __attribute__((ext_vector_type(4)));
typedef float f32x2 __attribute__((ext_vector_type(2)));
typedef short bf16x8 __attribute__((ext_vector_type(8)));
typedef GAS unsigned gu32;
#define RLX_AGENT __ATOMIC_RELAXED, __HIP_MEMORY_SCOPE_AGENT
#define LDS_WAIT() asm volatile("s_waitcnt lgkmcnt(0)" ::: "memory")
#define VM_WAIT() asm volatile("s_waitcnt vmcnt(0)" ::: "memory")
__device__ __forceinline__ unsigned pk2(float lo, float hi) { unsigned r; asm("v_cvt_pk_bf16_f32 %0, %1, %2" : "=v"(r) : "v"(lo), "v"(hi)); return r; }
__device__ __forceinline__ unsigned f2bf(float f) { return pk2(f, 0.f) & 0xffffu; }
__device__ __forceinline__ unsigned pk2q(float lo, float hi) { return __builtin_amdgcn_perm(__builtin_bit_cast(unsigned, hi) + 0x8000u, __builtin_bit_cast(unsigned, lo) + 0x8000u, 0x07060302u); }
__device__ __forceinline__ float bf2f(unsigned short b) { return __builtin_bit_cast(float, (unsigned)b << 16); }
__device__ __forceinline__ float dpp_shr1(float v) { return __builtin_bit_cast(float, __builtin_amdgcn_update_dpp(0, __builtin_bit_cast(int, v), 0x111, 0xf, 0xf, true)); }

__device__ __forceinline__ int opaque_tid() { int t = threadIdx.x; asm volatile("" : "+v"(t)); return t; }

__device__ __forceinline__ float wave_sum(float v) {
#pragma unroll
    for (int o = 1; o < 64; o <<= 1) v += __shfl_xor(v, o);
    return v;
}

constexpr float LOG2E = 1.4426950408889634f;
constexpr float QSCALE = 0.125f * LOG2E;

constexpr size_t MiB = 1u << 20;
constexpr size_t WS_CTL = 0, CTL_ZERO_BYTES = 1 * MiB;
constexpr size_t WS_WQKV = 1 * MiB;
constexpr size_t WS_WO = 7 * MiB;
constexpr size_t WS_WGLU = 11 * MiB;
constexpr size_t WS_WUP = 19 * MiB;
constexpr size_t WS_WDN = 63 * MiB;
constexpr size_t WS_XB = 85 * MiB;
constexpr size_t WS_SS = 118 * MiB;
constexpr size_t WS_Q = 121 * MiB;
constexpr size_t WS_K = 154 * MiB;
constexpr size_t WS_V = 163 * MiB;
constexpr size_t WS_O = 172 * MiB;
constexpr size_t WS_ACT = 205 * MiB;
constexpr size_t WS_HALO = 294 * MiB;
constexpr size_t WS_SSM = 316 * MiB;
constexpr size_t WS_END = 352 * MiB;

constexpr int CW_BAR = 4096;
namespace pg8 {
#define PG8_LAS __attribute__((address_space(3)))
typedef unsigned short bf16_t;
typedef short bf16x8 __attribute__((ext_vector_type(8)));
typedef float f32x4 __attribute__((ext_vector_type(4)));
typedef unsigned u32x4 __attribute__((ext_vector_type(4)));
constexpr int BM = 256, BK = 64, HALF = 128, HTB = HALF * BK * 2  , STAGE_BYTES = 8 * HTB, NXCD = 8, WGM = 8;

__host__ __device__ __forceinline__ int lds_byte(int r, int c) { const int st = (r >> 4) * 2 + (c >> 5), rr = r & 15, cc = c & 31, ob = rr * 64 + cc * 2; return st * 1024 + (ob ^ (((ob >> 9) & 1) << 5)); }
__host__ __device__ __forceinline__ void stage_rc(int b, int& R, int& C) { const int st = b / 1024, sb = b % 1024, swz = sb ^ (((sb >> 9) & 1) << 5); R = (st >> 1) * 16 + swz / 64; C = (st & 1) * 32 + (swz % 64) / 2; }
__host__ __device__ __forceinline__ int perm32(int rho) { const int n = rho >> 4, i = rho & 15; return 8 * (i >> 2) + 4 * n + (i & 3); }

struct Unit { int pm, pn; };
struct Gemm { const bf16_t* A; const bf16_t* Bt; int M, N, K; };

struct StaticOrder {
    int nM, nN, nwg, G, c;
    __host__ __device__ void init(int M, int N, int G_, int c_) { nM = M / BM; nN = N / BM; nwg = nM * nN; G = G_; c = c_; }
    __host__ __device__ bool next(int i, Unit& u) const {
        const long L = (long)i * G + c; if (L >= nwg) return false;
        int wgid = (int)L; { const int q = nwg / NXCD, r = nwg % NXCD, xcd = wgid % NXCD, off = wgid / NXCD; wgid = (xcd < r ? xcd * (q + 1) : r * (q + 1) + (xcd - r) * q) + off; }
        const int nig = WGM * nN, gid = wgid / nig, fm = gid * WGM, gsz = (nM - fm) < WGM ? (nM - fm) : WGM;
        u.pm = fm + ((wgid % nig) % gsz); u.pn = (wgid % nig) / gsz; return true;
    }
    __device__ __forceinline__ void a_ready(const Unit&) const {}
    __device__ __forceinline__ void done(const Unit&) const {}
};

__device__ __forceinline__ unsigned cvt_pk_bf16(float lo, float hi) { unsigned r; asm volatile("v_cvt_pk_bf16_f32 %0, %1, %2" : "=v"(r) : "v"(lo), "v"(hi)); return r; }
typedef unsigned u32x2 __attribute__((ext_vector_type(2)));
__device__ __forceinline__ void st_b32(void* p, float v) { asm volatile("global_store_dword %0, %1, off" :: "v"(p), "v"(v) : "memory"); }
__device__ __forceinline__ void st_b64(void* p, u32x2 v) { asm volatile("global_store_dwordx2 %0, %1, off" :: "v"(p), "v"(v) : "memory"); }
__device__ __forceinline__ void st_b64_nt(void* p, u32x2 v) { asm volatile("global_store_dwordx2 %0, %1, off nt" :: "v"(p), "v"(v) : "memory"); }
__device__ __forceinline__ void st_b128(void* p, u32x4 v) { asm volatile("global_store_dwordx4 %0, %1, off\n\ts_nop 1" :: "v"(p), "v"(v) : "memory"); }
__device__ __forceinline__ void st_f128_nt(void* p, f32x4 v) { asm volatile("global_store_dwordx4 %0, %1, off nt\n\ts_nop 1" :: "v"(p), "v"(v) : "memory"); }
__device__ __forceinline__ void st_f128(void* p, f32x4 v) { asm volatile("global_store_dwordx4 %0, %1, off\n\ts_nop 1" :: "v"(p), "v"(v) : "memory"); }

template <bool APERM>
__device__ __forceinline__ void row_scales(const float* __restrict__ ss, int np4  , int rowbase  , int lane, int fr, float (&rs)[2][4]) {
    const int mm = lane >> 4, ff = lane & 15, rloc = APERM ? (4 * ff + mm) : (16 * mm + ff);
    float v[2];
#pragma unroll
    for (int ai = 0; ai < 2; ++ai) {
        const f32x4* p = (const f32x4*)(ss + (size_t)(rowbase + 128 * ai + rloc) * 32);
        float s = 0.f;
        for (int i = 0; i < np4; ++i) { const f32x4 t = p[i]; s += (t[0] + t[1]) + (t[2] + t[3]); }
        v[ai] = __builtin_amdgcn_rsqf(s * (1.0f / 1024.0f) + 1e-6f);
    }
#pragma unroll
    for (int ai = 0; ai < 2; ++ai)
#pragma unroll
        for (int m = 0; m < 4; ++m) rs[ai][m] = __shfl(v[ai], 16 * m + fr);
}

struct EpiQKV {
    bf16_t* Q; bf16_t* Kb; bf16_t* Vb; PG8_LAS const float* rsl; PG8_LAS const float* qg; PG8_LAS const float* kg; float* kout; float* vout;
    __device__ __forceinline__ void operator()(const f32x4 (&acc)[2][2][4][2], const Unit& u, int ui, int wr, int wc, int fr, int fq) const {
        const int rowbase = u.pm * BM + wr * 64;
        float rs[2][4];
#pragma unroll
        for (int ai = 0; ai < 2; ++ai)
#pragma unroll
            for (int m = 0; m < 4; ++m) rs[ai][m] = rsl[ui * 256 + 128 * ai + 64 * wr + 16 * m + fr];
        const int kind = u.pn < 4 ? 0 : (u.pn == 4 ? 1 : 2);
        f32x4 gn[2][2];
#pragma unroll
        for (int bj = 0; bj < 2; ++bj)
#pragma unroll
            for (int n = 0; n < 2; ++n) gn[bj][n] = kind == 2 ? (f32x4){1.f, 1.f, 1.f, 1.f} : *(const PG8_LAS f32x4*)((kind == 0 ? qg : kg) + 32 * bj + 8 * fq + 4 * n);
        bf16_t* dst = kind == 0 ? Q + (size_t)(4 * u.pn + wc) * 64 : (kind == 1 ? Kb : Vb) + (size_t)wc * 64;
        const int pitch = kind == 0 ? 1024 : 256;
        const bool tail = (kind != 0) && ((u.pm & 15) == 15);
        float* fo = kind == 1 ? kout : vout;
#pragma unroll
        for (int ai = 0; ai < 2; ++ai)
#pragma unroll
            for (int m = 0; m < 4; ++m) {
                const int row = rowbase + 128 * ai + 16 * m + fr; const float r = rs[ai][m];
                f32x4 v[2][2]; float s = 0.f;
#pragma unroll
                for (int bj = 0; bj < 2; ++bj)
#pragma unroll
                    for (int n = 0; n < 2; ++n) { v[bj][n] = acc[ai][bj][m][n] * r; const f32x4 t = v[bj][n]; s += (t[0] * t[0] + t[1] * t[1]) + (t[2] * t[2] + t[3] * t[3]); }
                if (kind != 2) {
                    s += __shfl_xor(s, 16); s += __shfl_xor(s, 32);
                    const float hr = (__builtin_amdgcn_rsqf(s * (1.0f / 64.0f) + 1e-6f)) * (kind == 0 ? QSCALE : 1.0f);
#pragma unroll
                    for (int bj = 0; bj < 2; ++bj)
#pragma unroll
                        for (int n = 0; n < 2; ++n) v[bj][n] = v[bj][n] * hr * gn[bj][n];
                }
#pragma unroll
                for (int bj = 0; bj < 2; ++bj) {
                    u32x4 w; w.x = cvt_pk_bf16(v[bj][0][0], v[bj][0][1]); w.y = cvt_pk_bf16(v[bj][0][2], v[bj][0][3]); w.z = cvt_pk_bf16(v[bj][1][0], v[bj][1][1]); w.w = cvt_pk_bf16(v[bj][1][2], v[bj][1][3]);
                    st_b128(dst + (size_t)row * pitch + 32 * bj + 8 * fq, w);
                }
                if (tail && ai == 1) {
                    const int nb = u.pm >> 4, w = 16 * m + fr + 64 * wr;
                    float* o = fo + ((size_t)(nb * 128 + w)) * 256 + wc * 64 + 8 * fq;
#pragma unroll
                    for (int bj = 0; bj < 2; ++bj) { st_f128_nt(o + 32 * bj, v[bj][0]); st_f128_nt(o + 32 * bj + 4, v[bj][1]); }
                }
            }
    }
};

struct EpiRes {
    float* xout; bf16_t* xb; float* ss;
    __device__ __forceinline__ void operator()(const f32x4 (&acc)[2][2][4][2], const Unit& u, int ui, int wr, int wc, int fr, int fq) const {
        const int rowbase = u.pm * BM + wr * 64, col0 = u.pn * BM + wc * 32 + 8 * fq;
#pragma unroll
        for (int ai = 0; ai < 2; ++ai)
#pragma unroll
            for (int m = 0; m < 4; ++m) {
                const int row = rowbase + 128 * ai + 16 * m + fr; float s = 0.f;
                bf16_t* br = xb + (size_t)row * 1024 + col0;
                u32x4 xin[2];
#pragma unroll
                for (int bj = 0; bj < 2; ++bj) xin[bj] = *(const u32x4*)(br + bj * HALF);
                f32x2 s2 = {0.f, 0.f};
#pragma unroll
                for (int bj = 0; bj < 2; ++bj) {
                    const u32x4 xw = xin[bj];
                    f32x2 p[4]; u32x4 w;
#pragma unroll
                    for (int c = 0; c < 4; ++c) {
                        const unsigned xc = c == 0 ? xw.x : c == 1 ? xw.y : c == 2 ? xw.z : xw.w;
                        const f32x4 a4 = acc[ai][bj][m][c >> 1];
                        const f32x2 xv = {__builtin_bit_cast(float, xc << 16), __builtin_bit_cast(float, xc & 0xffff0000u)};
                        p[c] = (f32x2){a4[2 * (c & 1)], a4[2 * (c & 1) + 1]} + xv;
                        s2 = __builtin_elementwise_fma(p[c], p[c], s2);
                    }
                    w.x = cvt_pk_bf16(p[0].x, p[0].y); w.y = cvt_pk_bf16(p[1].x, p[1].y); w.z = cvt_pk_bf16(p[2].x, p[2].y); w.w = cvt_pk_bf16(p[3].x, p[3].y);
                    st_b128(br + bj * HALF, w);
                    if (xout) { float* xo = xout + (size_t)row * 1024 + col0 + bj * HALF; st_f128_nt(xo, (f32x4){p[0].x, p[0].y, p[1].x, p[1].y}); st_f128_nt(xo + 4, (f32x4){p[2].x, p[2].y, p[3].x, p[3].y}); }
                }
                s = s2.x + s2.y;
                s += __shfl_xor(s, 16); s += __shfl_xor(s, 32);
                if (fq == 0) st_b32(ss + (size_t)row * 32 + 4 * u.pn + wc, s);
                if (m & 1) asm volatile("" ::: "memory");
            }
    }
};

struct EpiGlu {
    bf16_t* xb; float* ss;
    __device__ __forceinline__ void operator()(const f32x4 (&acc)[2][2][4][2], const Unit& u, int ui, int wr, int wc, int fr, int fq) const {
        const int rowbase = u.pm * BM + wr * 64, col0 = u.pn * 128 + wc * 32 + 8 * fq;
#pragma unroll
        for (int ai = 0; ai < 2; ++ai)
#pragma unroll
            for (int m = 0; m < 4; ++m) {
                const int row = rowbase + 128 * ai + 16 * m + fr; float s = 0.f;
                bf16_t* br = xb + (size_t)row * 1024 + col0;
                const u32x4 xw = *(const u32x4*)br;
                f32x2 s2 = {0.f, 0.f}; u32x4 w;
#pragma unroll
                for (int c = 0; c < 4; ++c) {
                    const unsigned xc = c == 0 ? xw.x : c == 1 ? xw.y : c == 2 ? xw.z : xw.w;
                    const f32x4 a4 = acc[ai][0][m][c >> 1], b4 = acc[ai][1][m][c >> 1];
                    const f32x2 a2 = {a4[2 * (c & 1)], a4[2 * (c & 1) + 1]}, b2 = {b4[2 * (c & 1)], b4[2 * (c & 1) + 1]};
                    const f32x2 t2 = b2 * (f32x2){-LOG2E, -LOG2E};
                    const f32x2 d2 = (f32x2){__builtin_amdgcn_exp2f(t2.x), __builtin_amdgcn_exp2f(t2.y)} + (f32x2){1.0f, 1.0f};
                    const f32x2 r2 = {__builtin_amdgcn_rcpf(d2.x), __builtin_amdgcn_rcpf(d2.y)};
                    const f32x2 xv = {__builtin_bit_cast(float, xc << 16), __builtin_bit_cast(float, xc & 0xffff0000u)};
                    const f32x2 o2 = __builtin_elementwise_fma(a2, r2, xv);
                    s2 = __builtin_elementwise_fma(o2, o2, s2);
                    const unsigned wc_ = cvt_pk_bf16(o2.x, o2.y);
                    if (c == 0) w.x = wc_; else if (c == 1) w.y = wc_; else if (c == 2) w.z = wc_; else w.w = wc_;
                }
                s = s2.x + s2.y;
                st_b128(br, w);
                s += __shfl_xor(s, 16); s += __shfl_xor(s, 32);
                if (fq == 0) st_b32(ss + (size_t)row * 32 + 4 * u.pn + wc, s);
            }
    }
};

__device__ __forceinline__ f32x2 gate2(f32x2 g2, f32x2 ug, f32x2 gb, f32x2 g1, f32x2 a1, f32x2 g0, f32x2 a2, f32x2 h2, f32x2 uv, f32x2 hb, f32x2 h1, f32x2 b1, f32x2 h0, f32x2 b2, f32x2 nl2e, f32x2 one2) {
    f32x2 cg = __builtin_elementwise_fma(g2, ug, gb), cv = __builtin_elementwise_fma(h2, uv, hb);
    cg = __builtin_elementwise_fma(g1, a1, cg); cv = __builtin_elementwise_fma(h1, b1, cv);
    cg = __builtin_elementwise_fma(g0, a2, cg); cv = __builtin_elementwise_fma(h0, b2, cv);
    const f32x2 d = (f32x2){__builtin_amdgcn_exp2f(cg.x), __builtin_amdgcn_exp2f(cg.y)} + one2;
    const f32x2 r = {__builtin_amdgcn_rcpf(d.x), __builtin_amdgcn_rcpf(d.y)};
    return (cg * cv) * r;
}
#define PG8_LO2(v) __builtin_shufflevector(v, v, 0, 1)
#define PG8_HI2(v) __builtin_shufflevector(v, v, 2, 3)
struct EpiUp {
    bf16_t* act; float* halo; PG8_LAS const float* rsl; PG8_LAS const float* cvl;
    __device__ __forceinline__ void operator()(const f32x4 (&acc)[2][2][4][2], const Unit& u, int ui, int wr, int wc, int fr, int fq) const {
        const int rowbase = u.pm * BM + wr * 128, j0 = u.pn * 128 + wc * 32 + 8 * fq, blk = 2 * u.pm + wr;
        float rs[2][4];
#pragma unroll
        for (int ai = 0; ai < 2; ++ai) { const f32x4 t = *(const PG8_LAS f32x4*)(rsl + ui * 256 + 128 * wr + 8 * fr + 4 * ai); rs[ai][0] = t[0]; rs[ai][1] = t[1]; rs[ai][2] = t[2]; rs[ai][3] = t[3]; }
        const PG8_LAS float* cv0 = cvl + ui * 1024 + wc * 32 + 8 * fq;
        const f32x2 nl2e = {-LOG2E, -LOG2E}, one2 = {1.0f, 1.0f};
        u32x4 outw[2][4];
#pragma unroll
        for (int n = 0; n < 2; ++n) {
            const int j = j0 + 4 * n;
            const PG8_LAS float* cvn = cv0 + 4 * n;
            const f32x4 g0 = *(const PG8_LAS f32x4*)(cvn), g1 = *(const PG8_LAS f32x4*)(cvn + 128), g2 = *(const PG8_LAS f32x4*)(cvn + 256), gb = *(const PG8_LAS f32x4*)(cvn + 384);
            const f32x4 h0 = *(const PG8_LAS f32x4*)(cvn + 512), h1 = *(const PG8_LAS f32x4*)(cvn + 640), h2 = *(const PG8_LAS f32x4*)(cvn + 768), hb = *(const PG8_LAS f32x4*)(cvn + 896);
            f32x4 ug[2][4], uv[2][4];
#pragma unroll
            for (int ai = 0; ai < 2; ++ai)
#pragma unroll
                for (int m = 0; m < 4; ++m) { ug[ai][m] = acc[ai][0][m][n] * rs[ai][m]; uv[ai][m] = acc[ai][1][m][n] * rs[ai][m]; }
            if (fr == 0) {
#pragma unroll
                for (int m = 0; m < 2; ++m) { float* hp = halo + ((size_t)blk * 4 + m) * 5632 + j; st_f128(hp, ug[0][m]); st_f128(hp + 2816, uv[0][m]); }
            }
            if (fr == 15) {
#pragma unroll
                for (int m = 2; m < 4; ++m) { float* hp = halo + ((size_t)blk * 4 + m) * 5632 + j; st_f128(hp, ug[1][m]); st_f128(hp + 2816, uv[1][m]); }
            }
            f32x4 pg1, pg2, pv1, pv2;
#pragma unroll
            for (int e = 0; e < 4; ++e) { pg1[e] = dpp_shr1(ug[1][3][e]); pg2[e] = dpp_shr1(ug[1][2][e]); pv1[e] = dpp_shr1(uv[1][3][e]); pv2[e] = dpp_shr1(uv[1][2][e]); }
#pragma unroll
            for (int ai = 0; ai < 2; ++ai)
#pragma unroll
                for (int m = 0; m < 4; ++m) {
                    const f32x4 a1 = ai == 0 ? (m == 0 ? pg1 : ug[0][m > 0 ? m - 1 : 0]) : (m == 0 ? ug[0][3] : ug[1][m > 0 ? m - 1 : 0]);
                    const f32x4 a2 = ai == 0 ? (m == 0 ? pg2 : (m == 1 ? pg1 : ug[0][m > 1 ? m - 2 : 0])) : (m == 0 ? ug[0][2] : (m == 1 ? ug[0][3] : ug[1][m > 1 ? m - 2 : 0]));
                    const f32x4 b1 = ai == 0 ? (m == 0 ? pv1 : uv[0][m > 0 ? m - 1 : 0]) : (m == 0 ? uv[0][3] : uv[1][m > 0 ? m - 1 : 0]);
                    const f32x4 b2 = ai == 0 ? (m == 0 ? pv2 : (m == 1 ? pv1 : uv[0][m > 1 ? m - 2 : 0])) : (m == 0 ? uv[0][2] : (m == 1 ? uv[0][3] : uv[1][m > 1 ? m - 2 : 0]));
                    const f32x2 olo = gate2(PG8_LO2(g2), PG8_LO2(ug[ai][m]), PG8_LO2(gb), PG8_LO2(g1), PG8_LO2(a1), PG8_LO2(g0), PG8_LO2(a2), PG8_LO2(h2), PG8_LO2(uv[ai][m]), PG8_LO2(hb), PG8_LO2(h1), PG8_LO2(b1), PG8_LO2(h0), PG8_LO2(b2), nl2e, one2);
                    const f32x2 ohi = gate2(PG8_HI2(g2), PG8_HI2(ug[ai][m]), PG8_HI2(gb), PG8_HI2(g1), PG8_HI2(a1), PG8_HI2(g0), PG8_HI2(a2), PG8_HI2(h2), PG8_HI2(uv[ai][m]), PG8_HI2(hb), PG8_HI2(h1), PG8_HI2(b1), PG8_HI2(h0), PG8_HI2(b2), nl2e, one2);
                    if (n == 0) { outw[ai][m].x = cvt_pk_bf16(olo.x, olo.y); outw[ai][m].y = cvt_pk_bf16(ohi.x, ohi.y); } else { outw[ai][m].z = cvt_pk_bf16(olo.x, olo.y); outw[ai][m].w = cvt_pk_bf16(ohi.x, ohi.y); }
                }
        }
#pragma unroll
        for (int ai = 0; ai < 2; ++ai)
#pragma unroll
            for (int m = 0; m < 4; ++m) { const int row = rowbase + 8 * fr + 4 * ai + m;
                if (!(fr == 0 && ai == 0 && m < 2)) st_b128(act + (size_t)row * 2816 + j0, outw[ai][m]); }
        asm volatile("" ::: "memory");
    }
};
template <class Epi, class Sched, bool ALIGN_EPI = false, bool SP2 = false, bool APERM = false>
__device__ __forceinline__ void gemm_phase(PG8_LAS unsigned char* lds, const Gemm g, const Sched& S, const Epi& E) {
    const int tid = opaque_tid(), wid = __builtin_amdgcn_readfirstlane(tid >> 6), lane = tid & 63, wr = wid >> 2, wc = wid & 3, fr = lane & 15, fq = lane >> 4;
    const int K = g.K, nt = K / BK;
    unsigned voffA[2], voffB[2];
#pragma unroll
    for (int i = 0; i < 2; ++i) { int R, C; stage_rc(tid * 16 + i * 8192, R, C); const int Ra = APERM ? (((R & 64) << 1) | ((R & 15) << 3) | ((R >> 4) & 3)) : R;
        voffA[i] = (unsigned)(Ra * K + C) * 2u; voffB[i] = (unsigned)(R * K + C) * 2u; }
    const size_t kstep = (size_t)(BK * 2);
    const size_t hstep = (size_t)HALF * K * 2;
    const size_t hstepA = APERM ? (size_t)4 * K * 2 : hstep;
    const size_t tstep = 2 * hstep;
    const unsigned ldsw = (unsigned)wid * 1024u;
    const int aoff = lds_byte(wr * 64 + fr, fq * 8), boff = lds_byte(wc * 32 + fr, fq * 8);
#define PG8_SA(b, h) (((b) * 2 + (h)) * HTB)
#define PG8_SB(b, h) ((4 + (b) * 2 + (h)) * HTB)
#define PG8_STAGE(bufoff, gbase, voff) do { _Pragma("unroll") for (int _i = 0; _i < 2; ++_i) \
        __builtin_amdgcn_global_load_lds((const unsigned*)((const char*)(gbase) + (voff)[_i]), (PG8_LAS unsigned*)(lds + (bufoff) + ldsw + _i * 8192), 16, 0, 0); } while (0)
#define PG8_LDA(dst, b, h) do { _Pragma("unroll") for (int m = 0; m < 4; ++m) _Pragma("unroll") for (int k = 0; k < 2; ++k) dst[m][k] = *(const PG8_LAS bf16x8*)(lds + PG8_SA(b, h) + aoff + m * 2048 + k * 1024); } while (0)
#define PG8_LDB(dst, b, h) do { _Pragma("unroll") for (int n = 0; n < 2; ++n) _Pragma("unroll") for (int k = 0; k < 2; ++k) dst[n][k] = *(const PG8_LAS bf16x8*)(lds + PG8_SB(b, h) + boff + n * 2048 + k * 1024); } while (0)
#define PG8_MMA(ai, bj, At, Bt) do { __builtin_amdgcn_s_setprio(1); _Pragma("unroll") for (int m = 0; m < 4; ++m) _Pragma("unroll") for (int n = 0; n < 2; ++n) _Pragma("unroll") for (int k = 0; k < 2; ++k) \
        acc[ai][bj][m][n] = __builtin_amdgcn_mfma_f32_16x16x32_bf16(Bt[n][k], At[m][k], acc[ai][bj][m][n], 0, 0, 0); __builtin_amdgcn_s_setprio(0); } while (0)
#define PG8_WAIT_V(n) asm volatile("s_waitcnt vmcnt(" #n ")" ::: "memory")
#define PG8_WAIT_L(n) asm volatile("s_waitcnt lgkmcnt(" #n ")" ::: "memory")
#define PG8_BAR __builtin_amdgcn_s_barrier()
#define PG8_SCHED __builtin_amdgcn_sched_barrier(0)
    Unit cur, nxt; int ui = 0;
    if (!S.next(0, cur)) return;
    f32x4 acc[2][2][4][2];
#pragma unroll
    for (int a = 0; a < 2; ++a)
#pragma unroll
        for (int b = 0; b < 2; ++b)
#pragma unroll
            for (int m = 0; m < 4; ++m)
#pragma unroll
                for (int n = 0; n < 2; ++n) acc[a][b][m][n] = (f32x4){0.f, 0.f, 0.f, 0.f};
    bf16x8 At[4][2], B0[2][2], B1[2][2];
    const char* cA = (const char*)g.A + (size_t)cur.pm * tstep; const char* cB = (const char*)g.Bt + (size_t)cur.pn * tstep;
    S.a_ready(cur);
    if constexpr (SP2) {
        PG8_STAGE(PG8_SB(0, 0), cB, voffB); PG8_STAGE(PG8_SB(0, 1), cB + hstep, voffB); PG8_STAGE(PG8_SA(0, 0), cA, voffA); PG8_STAGE(PG8_SA(0, 1), cA + hstepA, voffA);
        if (wr == 1) PG8_BAR;
        PG8_WAIT_V(2); PG8_BAR;
        PG8_STAGE(PG8_SB(1, 0), cB + kstep, voffB); PG8_STAGE(PG8_SA(1, 0), cA + kstep, voffA); PG8_STAGE(PG8_SB(1, 1), cB + hstep + kstep, voffB);
        PG8_WAIT_V(6); PG8_BAR;
    } else {
        PG8_STAGE(PG8_SB(0, 0), cB, voffB); PG8_STAGE(PG8_SA(0, 0), cA, voffA); PG8_STAGE(PG8_SB(0, 1), cB + hstep, voffB); PG8_STAGE(PG8_SA(0, 1), cA + hstepA, voffA);
        if (wr == 1) PG8_BAR;
        PG8_WAIT_V(4); PG8_BAR;
        PG8_STAGE(PG8_SB(1, 0), cB + kstep, voffB); PG8_STAGE(PG8_SA(1, 0), cA + kstep, voffA); PG8_STAGE(PG8_SB(1, 1), cB + hstep + kstep, voffB);
        PG8_WAIT_V(6); PG8_BAR;
    }
    for (;;) {
        const bool has_next = S.next(ui + 1, nxt);
        const char* nA = has_next ? (const char*)g.A + (size_t)nxt.pm * tstep : cA; const char* nB = has_next ? (const char*)g.Bt + (size_t)nxt.pn * tstep : cB;
        for (int t = 0; t < nt; t += 2) {
            const bool last = (t == nt - 2);
            const char* a1 = cA + (size_t)(t + 1) * kstep;
            const char* a2 = last ? nA : cA + (size_t)(t + 2) * kstep; const char* b2 = last ? nB : cB + (size_t)(t + 2) * kstep;
            const char* a3 = a2 + kstep; const char* b3 = b2 + kstep;
            if (last && has_next) S.a_ready(nxt);
            if constexpr (SP2) {
            PG8_LDB(B0, 0, 0); PG8_LDB(B1, 0, 1); PG8_SCHED; PG8_LDA(At, 0, 0); PG8_STAGE(PG8_SA(1, 1), a1 + hstepA, voffA);
            PG8_WAIT_V(8); PG8_WAIT_L(0); PG8_BAR; PG8_MMA(0, 0, At, B0); PG8_MMA(0, 1, At, B1); PG8_BAR; PG8_SCHED;
            PG8_LDA(At, 0, 1); PG8_STAGE(PG8_SB(0, 0), b2, voffB); PG8_STAGE(PG8_SB(0, 1), b2 + hstep, voffB); PG8_STAGE(PG8_SA(0, 0), a2, voffA);
            PG8_WAIT_V(8); PG8_WAIT_L(0); PG8_BAR; PG8_MMA(1, 0, At, B0); PG8_MMA(1, 1, At, B1); PG8_BAR; PG8_SCHED;
            PG8_LDB(B0, 1, 0); PG8_LDB(B1, 1, 1); PG8_SCHED; PG8_LDA(At, 1, 0); PG8_STAGE(PG8_SA(0, 1), a2 + hstepA, voffA);
            PG8_WAIT_V(8); PG8_WAIT_L(0); PG8_BAR; PG8_MMA(0, 0, At, B0); PG8_MMA(0, 1, At, B1); PG8_BAR; PG8_SCHED;
            PG8_LDA(At, 1, 1); PG8_STAGE(PG8_SB(1, 0), b3, voffB); PG8_STAGE(PG8_SB(1, 1), b3 + hstep, voffB); PG8_STAGE(PG8_SA(1, 0), a3, voffA);
            PG8_WAIT_V(8); PG8_WAIT_L(0); PG8_BAR; PG8_MMA(1, 0, At, B0); PG8_MMA(1, 1, At, B1); PG8_BAR; PG8_SCHED;
            } else {
            PG8_LDB(B0, 0, 0); PG8_SCHED; PG8_LDA(At, 0, 0); PG8_STAGE(PG8_SA(1, 1), a1 + hstepA, voffA);
            PG8_WAIT_L(8); PG8_BAR; PG8_WAIT_L(0); PG8_MMA(0, 0, At, B0); PG8_BAR; PG8_SCHED;
            PG8_LDB(B1, 0, 1); PG8_STAGE(PG8_SB(0, 0), b2, voffB);
            PG8_BAR; PG8_WAIT_L(0); PG8_MMA(0, 1, At, B1); PG8_BAR;
            PG8_LDA(At, 0, 1); PG8_STAGE(PG8_SA(0, 0), a2, voffA);
            PG8_BAR; PG8_WAIT_L(0); PG8_MMA(1, 0, At, B0); PG8_BAR; PG8_SCHED;
            PG8_STAGE(PG8_SB(0, 1), b2 + hstep, voffB);
            PG8_WAIT_V(6); PG8_BAR; PG8_MMA(1, 1, At, B1); PG8_BAR;
            PG8_LDB(B0, 1, 0); PG8_SCHED; PG8_LDA(At, 1, 0); PG8_STAGE(PG8_SA(0, 1), a2 + hstepA, voffA);
            PG8_WAIT_L(8); PG8_BAR; PG8_WAIT_L(0); PG8_MMA(0, 0, At, B0); PG8_BAR; PG8_SCHED;
            PG8_LDB(B1, 1, 1); PG8_STAGE(PG8_SB(1, 0), b3, voffB);
            PG8_BAR; PG8_WAIT_L(0); PG8_MMA(0, 1, At, B1); PG8_BAR;
            PG8_LDA(At, 1, 1); PG8_STAGE(PG8_SA(1, 0), a3, voffA);
            PG8_BAR; PG8_WAIT_L(0); PG8_MMA(1, 0, At, B0); PG8_BAR; PG8_SCHED;
            PG8_STAGE(PG8_SB(1, 1), b3 + hstep, voffB);
            PG8_WAIT_V(6); PG8_BAR; PG8_MMA(1, 1, At, B1); PG8_BAR;
            }
        }
        if constexpr (ALIGN_EPI) { if (wr == 0) PG8_BAR; }
        {
            E(acc, cur, ui, wr, wc, fr, fq); S.done(cur);
        }
        if (!has_next) break;
#pragma unroll
        for (int a = 0; a < 2; ++a)
#pragma unroll
            for (int b = 0; b < 2; ++b)
#pragma unroll
                for (int m = 0; m < 4; ++m)
#pragma unroll
                    for (int n = 0; n < 2; ++n) acc[a][b][m][n] = (f32x4){0.f, 0.f, 0.f, 0.f};
        cur = nxt; cA = nA; cB = nB; ++ui;
        if constexpr (ALIGN_EPI) { if (wr == 1) PG8_BAR; }
    }
    PG8_WAIT_V(0);
    if constexpr (!ALIGN_EPI) { if (wr == 0) PG8_BAR; }
    PG8_BAR;
#undef PG8_SA
#undef PG8_SB
#undef PG8_STAGE
#undef PG8_LDA
#undef PG8_LDB
#undef PG8_MMA
#undef PG8_WAIT_V
#undef PG8_WAIT_L
#undef PG8_BAR
#undef PG8_SCHED
}
}


namespace att {
using s16x4 = __attribute__((ext_vector_type(4))) short;
using f32x16 = __attribute__((ext_vector_type(16))) float;
using u32x4 = __attribute__((ext_vector_type(4))) unsigned;
typedef LAS const char* lds_cptr;
constexpr int SLOTB = 8192, LDS_K = 0, LDS_V = 4 * SLOTB, LDS_WS = 8 * SLOTB, LDS_OST = LDS_WS + 8 * 256, LDS_BYTES = LDS_OST + 8 * 4096;
__device__ __forceinline__ int crow(int r, int hi) { return (r & 3) + 8 * (r >> 2) + 4 * hi; }
__device__ __forceinline__ void glds16_nt(const void* gsrc, unsigned lds_dst) { unsigned keep;
    asm volatile("s_mov_b32 %0, m0\n\ts_mov_b32 m0, %2\n\ts_nop 0\n\tglobal_load_lds_dwordx4 %1, off nt\n\ts_mov_b32 m0, %0" : "=&s"(keep) : "v"(gsrc), "s"(lds_dst) : "memory"); }
__device__ __forceinline__ void glds16(const void* gsrc, unsigned lds_dst) { unsigned keep;
    asm volatile("s_mov_b32 %0, m0\n\ts_mov_b32 m0, %2\n\ts_nop 0\n\tglobal_load_lds_dwordx4 %1, off\n\ts_mov_b32 m0, %0" : "=&s"(keep) : "v"(gsrc), "s"(lds_dst) : "memory"); }
typedef float f32x2_t __attribute__((ext_vector_type(2))); typedef __bf16 bf16x2_t __attribute__((ext_vector_type(2)));
__device__ __forceinline__ unsigned cvtpk_s(float lo, float hi) { f32x2_t v = {lo, hi}; bf16x2_t b = __builtin_convertvector(v, bf16x2_t); return __builtin_bit_cast(unsigned, b); }
__device__ __forceinline__ void qkt(f32x16& p0, f32x16& p1, lds_cptr kb  , const bf16x8* qr) {
    p0 = f32x16{}; p1 = f32x16{};
#pragma unroll
    for (int d0 = 0; d0 < 4; ++d0) {
        const bf16x8 b0 = *(const LAS bf16x8*)(kb + d0 * 2048);
        const bf16x8 b1 = *(const LAS bf16x8*)(kb + d0 * 2048 + 512);
        p0 = __builtin_amdgcn_mfma_f32_32x32x16_bf16(b0, qr[d0], p0, 0, 0, 0); p1 = __builtin_amdgcn_mfma_f32_32x32x16_bf16(b1, qr[d0], p1, 0, 0, 0); }
}
__device__ __forceinline__ void pv(f32x16* o, int vb, bf16x8 pa0, bf16x8 pa1, bf16x8 pa2, bf16x8 pa3) {
#pragma unroll
    for (int d0 = 0; d0 < 2; ++d0) { s16x4 lo[4], hi[4];
#pragma unroll
        for (int ks = 0; ks < 4; ++ks) {
            asm volatile("ds_read_b64_tr_b16 %0,%1 offset:%c2" : "=&v"(lo[ks]) : "v"(vb), "i"(d0 * 4096 + ks * 1024) : "memory");
            asm volatile("ds_read_b64_tr_b16 %0,%1 offset:%c2" : "=&v"(hi[ks]) : "v"(vb), "i"(d0 * 4096 + ks * 1024 + 512) : "memory"); }
        asm volatile("s_waitcnt lgkmcnt(0)" ::: "memory"); __builtin_amdgcn_sched_barrier(0);
#define ATT_PK(k) (bf16x8){lo[k][0], lo[k][1], lo[k][2], lo[k][3], hi[k][0], hi[k][1], hi[k][2], hi[k][3]}
        o[d0] = __builtin_amdgcn_mfma_f32_32x32x16_bf16(pa0, ATT_PK(0), o[d0], 0, 0, 0);
        o[d0] = __builtin_amdgcn_mfma_f32_32x32x16_bf16(pa1, ATT_PK(1), o[d0], 0, 0, 0);
        o[d0] = __builtin_amdgcn_mfma_f32_32x32x16_bf16(pa2, ATT_PK(2), o[d0], 0, 0, 0);
        o[d0] = __builtin_amdgcn_mfma_f32_32x32x16_bf16(pa3, ATT_PK(3), o[d0], 0, 0, 0);
#undef ATT_PK
    }
}
__device__ __forceinline__ float hswap_max(float m) { auto rr = __builtin_amdgcn_permlane32_swap(__float_as_uint(m), __float_as_uint(m), false, false); return fmaxf(__uint_as_float(rr[0]), __uint_as_float(rr[1])); }
__device__ __forceinline__ float hswap_sum(float m) { auto rr = __builtin_amdgcn_permlane32_swap(__float_as_uint(m), __float_as_uint(m), false, false); return __uint_as_float(rr[0]) + __uint_as_float(rr[1]); }

struct Roll { const f32x4* sk; const f32x4* sv; f32x4* dk; f32x4* dv; };
__device__ __forceinline__ void attn_units4(int n, int qb0, int kv, const bf16* Q, const bf16* __restrict__ K, const bf16* __restrict__ V, bf16* O, const float* __restrict__ sink, LAS char* shm, const Roll rl, int rid0) {
    asm volatile("" : "+s"(n), "+s"(qb0), "+s"(kv));
    const int tid = opaque_tid(), lane = tid & 63, r32 = lane & 31, hi = lane >> 5; const int wid = __builtin_amdgcn_readfirstlane(tid >> 6);
    const int g = wid >> 1, qh = wid & 1, h = kv * 4 + g; const long rowbase = (long)n * SEQ;
    const unsigned lds0 = (unsigned)(uintptr_t)shm;
    LAS float* wsf = (LAS float*)(shm + LDS_WS) + wid * 64;
    const bf16* kbase = K + (rowbase + lane) * 256 + kv * 64 + wid * 8;
    const bf16* vbase = V + (rowbase + 16 * (wid & 3) + (lane >> 2)) * 256 + kv * 64 + (wid >> 2) * 32 + (lane & 3) * 8;
    const bf16* Qw = Q + (rowbase + qh * 32 + r32) * 1024 + h * 64 + hi * 8;
    bf16* Ow = O + (rowbase + qh * 32) * 1024 + h * 64;
    LAS bf16* stg = (LAS bf16*)(shm + LDS_OST) + wid * 2048;
    const float sk2 = sink[h] * LOG2E;
#define ATT_TILE(kt) do { const int kt_ = (kt); if (kt_ >= 0) { const int so_ = (kt_ & 3) * SLOTB + wid * 1024; \
        glds16(kbase + (long)kt_ * 64 * 256, (unsigned)__builtin_amdgcn_readfirstlane(lds0 + LDS_K + so_)); glds16(vbase + (long)kt_ * 64 * 256, (unsigned)__builtin_amdgcn_readfirstlane(lds0 + LDS_V + so_)); } } while (0)
    ATT_TILE(qb0 - 2); ATT_TILE(qb0 - 1); ATT_TILE(qb0);
    bf16x8 qr[4], qn[4];
#pragma unroll
    for (int d0 = 0; d0 < 4; ++d0) { qr[d0] = *reinterpret_cast<const bf16x8*>(Qw + (long)qb0 * 64 * 1024 + d0 * 16); qn[d0] = qr[d0]; }
    f32x4 ck0 = {}, ck1 = {}, cv0 = {}, cv1 = {}; size_t cd0 = 0, cd1 = 0; bool c0 = false, c1 = false, pend = false;
#pragma unroll 1
    for (int i = 0; i < 4; ++i) {
        const int qb = qb0 + i;
        asm volatile("s_waitcnt vmcnt(0) lgkmcnt(0)\n\ts_barrier" ::: "memory");
        if (i < 3) { ATT_TILE(qb + 1);
#pragma unroll
            for (int d0 = 0; d0 < 4; ++d0) qn[d0] = *reinterpret_cast<const bf16x8*>(Qw + (long)(qb + 1) * 64 * 1024 + d0 * 16); }
        if (pend) {
#pragma unroll
            for (int j = 0; j < 4; ++j) { const int row = j * 8 + (lane >> 3), ch = lane & 7; const u32x4 v = *(const LAS u32x4*)(stg + row * 64 + ch * 8); __builtin_nontemporal_store(v, (u32x4*)(Ow + ((long)(qb - 1) * 64 + row) * 1024 + ch * 8)); }
            if (c0) { __builtin_nontemporal_store(ck0, rl.dk + cd0); __builtin_nontemporal_store(cv0, rl.dv + cd0); }
            if (c1) { __builtin_nontemporal_store(ck1, rl.dk + cd1); __builtin_nontemporal_store(cv1, rl.dv + cd1); }
            asm volatile("s_waitcnt lgkmcnt(0)" ::: "memory"); }
        c0 = false; c1 = false;
        if (rid0 >= 0) { const int e0 = (rid0 + i) * 512 + tid, e1 = e0 + 1024 * 512;
            c0 = true; { const int nn = e0 / (127 * 64); cd0 = (size_t)nn * 128 * 64 + (e0 - nn * (127 * 64)); ck0 = __builtin_nontemporal_load(rl.sk + cd0 + 64); cv0 = __builtin_nontemporal_load(rl.sv + cd0 + 64); }
            c1 = e1 < 128 * 127 * 64; if (c1) { const int nn = e1 / (127 * 64); cd1 = (size_t)nn * 128 * 64 + (e1 - nn * (127 * 64)); ck1 = __builtin_nontemporal_load(rl.sk + cd1 + 64); cv1 = __builtin_nontemporal_load(rl.sv + cd1 + 64); } }
        const int jlo = qb == 0 ? 2 : (qb == 1 ? 1 : 0);
        const int s0 = ((qb - 2) & 3) * SLOTB, s1 = ((qb - 1) & 3) * SLOTB, s2 = (qb & 3) * SLOTB;
        const lds_cptr kp0 = (lds_cptr)shm + LDS_K + hi * 1024 + r32 * 16;
        const int vb0 = (int)(lds0 + LDS_V) + ((lane >> 4) & 1) * 32 + (lane & 3) * 8 + (4 * hi + ((lane & 15) >> 2)) * 64;
        const float NEG = -INFINITY;
        f32x16 p00, p01, p10, p11, p20, p21;
        if (jlo <= 0) qkt(p00, p01, kp0 + s0, qr); else { for (int r = 0; r < 16; ++r) { p00[r] = NEG; p01[r] = NEG; } }
        if (jlo <= 1) qkt(p10, p11, kp0 + s1, qr); else { for (int r = 0; r < 16; ++r) { p10[r] = NEG; p11[r] = NEG; } }
        qkt(p20, p21, kp0 + s2, qr);
        const int qrel = qh * 32 + r32;
#pragma unroll
        for (int r = 0; r < 16; ++r) { const int kk = crow(r, hi);
            if (kk < qrel + 1) p00[r] = NEG; if (kk + 32 < qrel + 1) p01[r] = NEG;
            if (kk > qrel) p20[r] = NEG; if (kk + 32 > qrel) p21[r] = NEG; }
        float mx = sk2;
#pragma unroll
        for (int r = 0; r < 16; ++r) { mx = fmaxf(fmaxf(mx, p00[r]), p01[r]); mx = fmaxf(fmaxf(mx, p10[r]), p11[r]); mx = fmaxf(fmaxf(mx, p20[r]), p21[r]); }
        mx = hswap_max(mx);
        f32x2_t ls2 = {0.f, 0.f}; const f32x2_t mx2 = {mx, mx};
#define ATT_EXP2(P) do { _Pragma("unroll") for (int r = 0; r < 16; r += 2) { const f32x2_t d_ = (f32x2_t){P[r], P[r + 1]} - mx2; \
            const f32x2_t e_ = {__builtin_amdgcn_exp2f(d_.x), __builtin_amdgcn_exp2f(d_.y)}; P[r] = e_.x; P[r + 1] = e_.y; ls2 += e_; } } while (0)
        ATT_EXP2(p00); ATT_EXP2(p01); ATT_EXP2(p10); ATT_EXP2(p11); ATT_EXP2(p20); ATT_EXP2(p21);
#undef ATT_EXP2
        float ls = ls2.x + ls2.y;
        ls = hswap_sum(ls) + __builtin_amdgcn_exp2f(sk2 - mx);
        f32x16 o[2]; o[0] = f32x16{}; o[1] = f32x16{};
#define ATT_PKW(P, B) cvtpk_s(P[B], P[B + 1])
#define ATT_PVT(PA, PB, SO) do { const u32x4 w0 = (u32x4){ATT_PKW(PA, 0), ATT_PKW(PA, 2), ATT_PKW(PA, 4), ATT_PKW(PA, 6)}, w1 = (u32x4){ATT_PKW(PA, 8), ATT_PKW(PA, 10), ATT_PKW(PA, 12), ATT_PKW(PA, 14)}, \
        w2 = (u32x4){ATT_PKW(PB, 0), ATT_PKW(PB, 2), ATT_PKW(PB, 4), ATT_PKW(PB, 6)}, w3 = (u32x4){ATT_PKW(PB, 8), ATT_PKW(PB, 10), ATT_PKW(PB, 12), ATT_PKW(PB, 14)}; \
        pv(o, vb0 + (SO), __builtin_bit_cast(bf16x8, w0), __builtin_bit_cast(bf16x8, w1), __builtin_bit_cast(bf16x8, w2), __builtin_bit_cast(bf16x8, w3)); } while (0)
        if (jlo <= 0) ATT_PVT(p00, p01, s0);
        if (jlo <= 1) ATT_PVT(p10, p11, s1);
        ATT_PVT(p20, p21, s2);
#undef ATT_PVT
#undef ATT_PKW
        if (hi == 0) wsf[32 + r32] = ls; asm volatile("s_waitcnt lgkmcnt(0)" ::: "memory");
        float rli[16];
#pragma unroll
        for (int r = 0; r < 16; ++r) rli[r] = __builtin_amdgcn_rcpf(wsf[32 + crow(r, hi)]);
#pragma unroll
        for (int r = 0; r < 16; ++r) { const int orow = crow(r, hi);
#pragma unroll
            for (int d0 = 0; d0 < 2; ++d0) stg[orow * 64 + d0 * 32 + r32] = (bf16)f2bf(o[d0][r] * rli[r]); }
        pend = true;
#pragma unroll
        for (int d0 = 0; d0 < 4; ++d0) qr[d0] = qn[d0];
    }
#undef ATT_TILE
    asm volatile("s_waitcnt lgkmcnt(0)" ::: "memory");
#pragma unroll
    for (int j = 0; j < 4; ++j) { const int row = j * 8 + (lane >> 3), ch = lane & 7; const u32x4 v = *(const LAS u32x4*)(stg + row * 64 + ch * 8); __builtin_nontemporal_store(v, (u32x4*)(Ow + ((long)(qb0 + 3) * 64 + row) * 1024 + ch * 8)); }
    if (c0) { __builtin_nontemporal_store(ck0, rl.dk + cd0); __builtin_nontemporal_store(cv0, rl.dv + cd0); }
    if (c1) { __builtin_nontemporal_store(ck1, rl.dk + cd1); __builtin_nontemporal_store(cv1, rl.dv + cd1); }
    asm volatile("s_waitcnt lgkmcnt(0)\n\ts_barrier" ::: "memory");
}
}
namespace ssm {
using f32x16 = __attribute__((ext_vector_type(16))) float;
using s16x4 = __attribute__((ext_vector_type(4))) short;
constexpr int XT_PITCH = 144, XT_BYTES = 128 * XT_PITCH, WREG = XT_BYTES + 256;
constexpr size_t T_AB = 0, T_BBT = 32768, T_CCT = T_BBT + 262144, T_DG = T_CCT + 262144, T_BYTES = 1u << 20;
__device__ __forceinline__ float fma_s(float a, float b, float c) { float r; asm("v_fma_f32 %0, %1, %2, %3" : "=v"(r) : "v"(a), "v"(b), "v"(c)); return r; }
__device__ __forceinline__ float mul_s(float a, float b) { float r; asm("v_mul_f32_e32 %0, %1, %2" : "=v"(r) : "v"(a), "v"(b)); return r; }
__device__ __forceinline__ float cstep(float p_, float a, float q, float b, float s_, float d) { float r; asm("v_mul_f32_e32 %0, %5, %6\n\tv_fma_f32 %0, %3, %4, %0\n\tv_fma_f32 %0, %1, %2, %0" : "=&v"(r) : "v"(p_), "v"(a), "v"(q), "v"(b), "v"(s_), "v"(d)); return r; }
__device__ __forceinline__ void cstep4(float& x0r, float& x0i, float& x1r, float& x1i, float a0x, float a0y, float na0y, float a1x, float a1y, float na1y, float s_, float d0_, float d2_, float d1_, float d3_) {
    float n0r, n0i, n1r, n1i;
    asm("v_mul_f32_e32 %0, %14, %15\n\tv_mul_f32_e32 %1, %14, %16\n\tv_mul_f32_e32 %2, %14, %17\n\tv_mul_f32_e32 %3, %14, %18\n\t"
        "v_fma_f32 %0, %6, %11, %0\n\tv_fma_f32 %1, %5, %10, %1\n\tv_fma_f32 %2, %9, %13, %2\n\tv_fma_f32 %3, %8, %12, %3\n\t"
        "v_fma_f32 %0, %4, %10, %0\n\tv_fma_f32 %1, %4, %11, %1\n\tv_fma_f32 %2, %7, %12, %2\n\tv_fma_f32 %3, %7, %13, %3"
        : "=&v"(n0r), "=&v"(n0i), "=&v"(n1r), "=&v"(n1i)
        : "v"(a0x), "v"(a0y), "v"(na0y), "v"(a1x), "v"(a1y), "v"(na1y), "v"(x0r), "v"(x0i), "v"(x1r), "v"(x1i), "v"(s_), "v"(d0_), "v"(d2_), "v"(d1_), "v"(d3_));
    x0r = n0r; x0i = n0i; x1r = n1r; x1i = n1i;
}
__device__ __forceinline__ int tokmap(int T, int i) { return 32 * ((i >> 2) & 1) + 16 * T + 4 * (i >> 3) + (i & 3); }

struct Tab { const float* ab; const bf16* bbt; const bf16* cct; const float* dg; };
__device__ __forceinline__ Tab tab_of(unsigned char* ws, int jm) { unsigned char* b = ws + WS_SSM + (size_t)jm * T_BYTES; return Tab{(const float*)(b + T_AB), (const bf16*)(b + T_BBT), (const bf16*)(b + T_CCT), (const float*)(b + T_DG)}; }

__device__ __forceinline__ void build_tables(unsigned char* ws, int jm, int gp, const float* a_re, const float* a_im, const float* log_dt, const float* b_re, const float* b_im,
                                             const float* c_re, const float* c_im, const float* dsk, const float* gain) {
    unsigned char* b = ws + WS_SSM + (size_t)jm * T_BYTES;
    float* AB = (float*)(b + T_AB); bf16* BBT = (bf16*)(b + T_BBT); bf16* CCT = (bf16*)(b + T_CCT); float* DG = (float*)(b + T_DG);
    const int g = gp >> 6, p = gp & 63;
    const float dt = expf(log_dt[g]), ar = a_re[gp], ai = a_im[gp];
    const float mag = expf(ar * dt); float sn, cs; sincosf(ai * dt, &sn, &cs);
    const float abr = mag * cs, abi = mag * sn, den = ar * ar + ai * ai;
    const float cr = ((abr - 1.0f) * ar + abi * ai) / den, ci = (abi * ar - (abr - 1.0f) * ai) / den;
    *(float2*)(AB + 2 * gp) = make_float2(abr, abi);
    const float4* br4 = (const float4*)(b_re + (size_t)gp * 16); const float4* bi4 = (const float4*)(b_im + (size_t)gp * 16); const float4* gn4 = (const float4*)(gain + g * 16);
    uint4* dre = (uint4*)(BBT + ((size_t)g * 128 + p) * 16); uint4* dim = (uint4*)(BBT + ((size_t)g * 128 + 64 + p) * 16);
#pragma unroll
    for (int h = 0; h < 2; ++h) {
        const float4 r0 = br4[2 * h], r1 = br4[2 * h + 1], i0 = bi4[2 * h], i1 = bi4[2 * h + 1], g0 = gn4[2 * h], g1 = gn4[2 * h + 1];
        uint4 vr, vi;
        vr.x = pk2((cr * r0.x - ci * i0.x) * g0.x, (cr * r0.y - ci * i0.y) * g0.y); vr.y = pk2((cr * r0.z - ci * i0.z) * g0.z, (cr * r0.w - ci * i0.w) * g0.w);
        vr.z = pk2((cr * r1.x - ci * i1.x) * g1.x, (cr * r1.y - ci * i1.y) * g1.y); vr.w = pk2((cr * r1.z - ci * i1.z) * g1.z, (cr * r1.w - ci * i1.w) * g1.w);
        vi.x = pk2((cr * i0.x + ci * r0.x) * g0.x, (cr * i0.y + ci * r0.y) * g0.y); vi.y = pk2((cr * i0.z + ci * r0.z) * g0.z, (cr * i0.w + ci * r0.w) * g0.w);
        vi.z = pk2((cr * i1.x + ci * r1.x) * g1.x, (cr * i1.y + ci * r1.y) * g1.y); vi.w = pk2((cr * i1.z + ci * r1.z) * g1.z, (cr * i1.w + ci * r1.w) * g1.w);
        dre[h] = vr; dim[h] = vi;
    }
    for (int c = 0; c < 16; ++c) {
        CCT[((size_t)g * 16 + c) * 128 + p] = (bf16)f2bf(c_re[((size_t)g * 16 + c) * 64 + p]);
        CCT[((size_t)g * 16 + c) * 128 + 64 + p] = (bf16)f2bf(-c_im[((size_t)g * 16 + c) * 64 + p]);
    }
    if (p < 16) DG[g * 16 + p] = dsk[g * 16 + p] * gain[g * 16 + p];
}

template <bool FINAL>
__device__ __forceinline__ void unit(int n, int chunk, const Tab T, const bf16* __restrict__ XB, const float* __restrict__ SS, f32x2* __restrict__ EC, bf16* __restrict__ Z, LAS unsigned char* L) {
    const int tid = opaque_tid(), lane = tid & 63, r32 = lane & 31, hi = lane >> 5; const int wave = __builtin_amdgcn_readfirstlane(tid >> 6);
    LAS unsigned char* wl = L + wave * WREG; LAS float* rsb = (LAS float*)(wl + XT_BYTES);
    const int row0 = n * SEQ + chunk * 64;
    { const f32x4* p = (const f32x4*)(SS + (size_t)(row0 + lane) * 32); float s = 0.f;
#pragma unroll
      for (int i = 0; i < 4; ++i) { const f32x4 t = p[i]; s += (t[0] + t[1]) + (t[2] + t[3]); }
      rsb[lane] = __builtin_amdgcn_rsqf(s * (1.0f / 1024.0f) + 1e-6f); }
    LDS_WAIT(); asm volatile("" ::: "memory");
    const int run = 2 * chunk + hi;
    bf16x8 a_n[2], b_n[4]; f32x2 A0_n, A1_n, c0_n = {0.f, 0.f}, c1_n = {0.f, 0.f};
#define SSM_LOAD(G) do { _Pragma("unroll") for (int t = 0; t < 2; ++t) a_n[t] = *(const bf16x8*)(XB + (size_t)(row0 + tokmap(t, r32)) * 1024 + (G) * 16 + 8 * hi); \
        _Pragma("unroll") for (int cb = 0; cb < 4; ++cb) b_n[cb] = *(const bf16x8*)(T.bbt + ((size_t)(G) * 128 + 32 * cb + r32) * 16 + 8 * hi); \
        A0_n = *(const f32x2*)(T.ab + 2 * ((G) * 64 + r32)); A1_n = *(const f32x2*)(T.ab + 2 * ((G) * 64 + 32 + r32)); \
        if (FINAL) { const f32x2* ec_ = EC + ((size_t)(n * 128 + run) * 64 + (G)) * 64; c0_n = __builtin_nontemporal_load(ec_ + r32); c1_n = __builtin_nontemporal_load(ec_ + 32 + r32); } } while (0)
    SSM_LOAD(wave * 8);
#pragma unroll 1
    for (int gi = 0; gi < 8; ++gi) {
        const int g = wave * 8 + gi;
        bf16x8 a[2], b[4];
#pragma unroll
        for (int t = 0; t < 2; ++t) a[t] = a_n[t];
#pragma unroll
        for (int cb = 0; cb < 4; ++cb) b[cb] = b_n[cb];
        const f32x2 A0 = A0_n, A1 = A1_n; const f32x2 c0 = c0_n, c1 = c1_n;
        v2u xwc[4]; bf16x8 ca[4];
        if (FINAL) {
#pragma unroll
            for (int tt = 0; tt < 4; ++tt) { xwc[tt] = *(const v2u*)(XB + (size_t)(row0 + 16 * tt + (lane & 15)) * 1024 + g * 16 + 4 * (lane >> 4)); ca[tt] = *(const bf16x8*)(T.cct + ((size_t)g * 16 + (lane & 15)) * 128 + 32 * tt + 8 * (lane >> 4)); }
        }
        if (gi < 7) SSM_LOAD(g + 1);
        float x0r = c0.x, x0i = c0.y, x1r = c1.x, x1i = c1.y;
        f32x2* ec = EC + ((size_t)(n * 128 + run) * 64 + g) * 64;
#pragma unroll
        for (int t = 0; t < 2; ++t) {
            float rs[16];
#pragma unroll
            for (int k = 0; k < 4; ++k) { const f32x4 tq = *(const LAS f32x4*)(rsb + 32 * hi + 16 * t + 4 * k); rs[4 * k] = tq[0]; rs[4 * k + 1] = tq[1]; rs[4 * k + 2] = tq[2]; rs[4 * k + 3] = tq[3]; }
            const f32x16 z16 = f32x16{};
            f32x16 d0 = __builtin_amdgcn_mfma_f32_32x32x16_bf16(a[t], b[0], z16, 0, 0, 0), d1 = __builtin_amdgcn_mfma_f32_32x32x16_bf16(a[t], b[1], z16, 0, 0, 0);
            f32x16 d2 = __builtin_amdgcn_mfma_f32_32x32x16_bf16(a[t], b[2], z16, 0, 0, 0), d3 = __builtin_amdgcn_mfma_f32_32x32x16_bf16(a[t], b[3], z16, 0, 0, 0);
            asm volatile("s_nop 15\n\ts_nop 7" : "+v"(d0), "+v"(d1), "+v"(d2), "+v"(d3));
            const float nA0y = -A0.y, nA1y = -A1.y;
#pragma unroll
            for (int hf = 0; hf < 2; ++hf) {
                float o0r[8], o0i[8], o1r[8], o1i[8];
#pragma unroll
                for (int r8 = 0; r8 < 8; ++r8) {
                    const int r = 8 * hf + r8; const float s = rs[r];
                    cstep4(x0r, x0i, x1r, x1i, A0.x, A0.y, nA0y, A1.x, A1.y, nA1y, s, d0[r], d2[r], d1[r], d3[r]);
                    const float n0r = x0r, n0i = x0i, n1r = x1r, n1i = x1i;
                    if (FINAL) { o0r[r8] = n0r; o0i[r8] = n0i; o1r[r8] = n1r; o1i[r8] = n1i; }
                }
                if (FINAL) {
                    const int cofs = (32 * hi + 16 * t + 8 * hf) * 2;
                    v4u w0, w1, w2, w3;
                    w0.x = pg8::cvt_pk_bf16(o0r[0], o0r[1]); w0.y = pg8::cvt_pk_bf16(o0r[2], o0r[3]); w0.z = pg8::cvt_pk_bf16(o0r[4], o0r[5]); w0.w = pg8::cvt_pk_bf16(o0r[6], o0r[7]);
                    w1.x = pg8::cvt_pk_bf16(o1r[0], o1r[1]); w1.y = pg8::cvt_pk_bf16(o1r[2], o1r[3]); w1.z = pg8::cvt_pk_bf16(o1r[4], o1r[5]); w1.w = pg8::cvt_pk_bf16(o1r[6], o1r[7]);
                    w2.x = pg8::cvt_pk_bf16(o0i[0], o0i[1]); w2.y = pg8::cvt_pk_bf16(o0i[2], o0i[3]); w2.z = pg8::cvt_pk_bf16(o0i[4], o0i[5]); w2.w = pg8::cvt_pk_bf16(o0i[6], o0i[7]);
                    w3.x = pg8::cvt_pk_bf16(o1i[0], o1i[1]); w3.y = pg8::cvt_pk_bf16(o1i[2], o1i[3]); w3.z = pg8::cvt_pk_bf16(o1i[4], o1i[5]); w3.w = pg8::cvt_pk_bf16(o1i[6], o1i[7]);
                    *(LAS v4u*)(wl + (r32) * XT_PITCH + cofs) = w0; *(LAS v4u*)(wl + (32 + r32) * XT_PITCH + cofs) = w1;
                    *(LAS v4u*)(wl + (64 + r32) * XT_PITCH + cofs) = w2; *(LAS v4u*)(wl + (96 + r32) * XT_PITCH + cofs) = w3;
                    asm volatile("s_nop 1" ::: "memory"); __builtin_amdgcn_sched_barrier(0);
                }
            }
        }
        if (!FINAL) { const f32x2 e0 = {x0r, x0i}, e1 = {x1r, x1i}; pg8::st_b64_nt(ec + r32, __builtin_bit_cast(v2u, e0)); pg8::st_b64_nt(ec + 32 + r32, __builtin_bit_cast(v2u, e1)); }
        else {
            LDS_WAIT(); asm volatile("" ::: "memory");
            const int i16 = lane & 15, kq = lane >> 4;
            const f32x4 dg = *(const f32x4*)(T.dg + g * 16 + 4 * kq);
            const unsigned trb = (unsigned)(uintptr_t)wl + (8 * kq + (i16 >> 2)) * XT_PITCH + (4 * (i16 & 3)) * 2;
            s16x4 lo[4][4], hh[4][4];
#pragma unroll
            for (int tt = 0; tt < 4; ++tt)
#pragma unroll
                for (int ks = 0; ks < 4; ++ks) {
                    asm volatile("ds_read_b64_tr_b16 %0,%1 offset:%c2" : "=&v"(lo[tt][ks]) : "v"(trb), "i"(ks * 32 * XT_PITCH + tt * 32) : "memory");
                    asm volatile("ds_read_b64_tr_b16 %0,%1 offset:%c2" : "=&v"(hh[tt][ks]) : "v"(trb), "i"(ks * 32 * XT_PITCH + 4 * XT_PITCH + tt * 32) : "memory"); }
            asm volatile("s_waitcnt lgkmcnt(0)" ::: "memory"); __builtin_amdgcn_sched_barrier(0);
            f32x4 acc4[4];
#pragma unroll
            for (int tt = 0; tt < 4; ++tt) acc4[tt] = (f32x4){0.f, 0.f, 0.f, 0.f};
#pragma unroll
            for (int ks = 0; ks < 4; ++ks)
#pragma unroll
                for (int tt = 0; tt < 4; ++tt) { const bf16x8 bb = (bf16x8){lo[tt][ks][0], lo[tt][ks][1], lo[tt][ks][2], lo[tt][ks][3], hh[tt][ks][0], hh[tt][ks][1], hh[tt][ks][2], hh[tt][ks][3]};
                    acc4[tt] = __builtin_amdgcn_mfma_f32_16x16x32_bf16(ca[ks], bb, acc4[tt], 0, 0, 0); }
#pragma unroll
            for (int tt = 0; tt < 4; ++tt) {
                const f32x4 acc = acc4[tt];
                const int tok = 16 * tt + i16; const size_t row = (size_t)(row0 + tok);
                const v2u xw = xwc[tt];
                const float rt = rsb[tok];
                const float h0 = __builtin_bit_cast(float, xw.x << 16), h1 = __builtin_bit_cast(float, xw.x & 0xffff0000u), h2 = __builtin_bit_cast(float, xw.y << 16), h3 = __builtin_bit_cast(float, xw.y & 0xffff0000u);
                const f32x2 dr0 = {dg[0] * rt, dg[1] * rt}, dr1 = {dg[2] * rt, dg[3] * rt};
                f32x2 ya = (f32x2){acc[0], acc[1]} + dr0 * (f32x2){h0, h1}, yb = (f32x2){acc[2], acc[3]} + dr1 * (f32x2){h2, h3};
                const f32x2 ua = (ya * ya * 0.044715f + 1.0f) * ya * (-1.5957691216057308f * LOG2E), ub = (yb * yb * 0.044715f + 1.0f) * yb * (-1.5957691216057308f * LOG2E);
                f32x2 ea, eb; ea.x = __builtin_amdgcn_exp2f(ua.x); ea.y = __builtin_amdgcn_exp2f(ua.y); eb.x = __builtin_amdgcn_exp2f(ub.x); eb.y = __builtin_amdgcn_exp2f(ub.y);
                ea = ea + 1.0f; eb = eb + 1.0f;
                f32x2 ra, rb; ra.x = __builtin_amdgcn_rcpf(ea.x); ra.y = __builtin_amdgcn_rcpf(ea.y); rb.x = __builtin_amdgcn_rcpf(eb.x); rb.y = __builtin_amdgcn_rcpf(eb.y);
                ya = ya * ra; yb = yb * rb;
                v2u zw; zw.x = pg8::cvt_pk_bf16(ya.x, ya.y); zw.y = pg8::cvt_pk_bf16(yb.x, yb.y);
                pg8::st_b64(Z + row * 1024 + g * 16 + 4 * kq, zw);
            }
            LDS_WAIT(); asm volatile("" ::: "memory");
        }
    }
}

__device__ __forceinline__ void carries(int vcu, int G, const Tab T, const f32x2* __restrict__ E, f32x2* __restrict__ CIN, float* __restrict__ out_re, float* __restrict__ out_im) {
    const int tid = opaque_tid(), lane = tid & 63, j = lane >> 3;
    for (int wv = vcu * 8 + (tid >> 6); wv < 2048; wv += G * 8) {
        const int Lb = wv * 8 + (lane & 7), n = Lb >> 12, gp = Lb & 4095;
        f32x2 A = *(const f32x2*)(T.ab + 2 * gp);
#pragma unroll
        for (int s = 0; s < 5; ++s) A = f32x2{A.x * A.x - A.y * A.y, 2.f * A.x * A.y};
        f32x2 loc[16]; f32x2 c = {0.f, 0.f};
        const f32x2* e = E + ((size_t)(n * 128 + 16 * j)) * 4096 + gp;
#pragma unroll
        for (int k = 0; k < 16; ++k) { loc[k] = c; const f32x2 ev = __builtin_nontemporal_load(e + (size_t)k * 4096); c = f32x2{A.x * c.x - A.y * c.y + ev.x, A.x * c.y + A.y * c.x + ev.y}; }
        f32x2 P = A;
#pragma unroll
        for (int s = 0; s < 4; ++s) P = f32x2{P.x * P.x - P.y * P.y, 2.f * P.x * P.y};
        f32x2 carry = {0.f, 0.f}, mine = {0.f, 0.f};
#pragma unroll
        for (int i = 0; i < 8; ++i) { const float er = __shfl(c.x, (lane & 7) + 8 * i), ei = __shfl(c.y, (lane & 7) + 8 * i); if (i == j) mine = carry;
            carry = f32x2{P.x * carry.x - P.y * carry.y + er, P.x * carry.y + P.y * carry.x + ei}; }
        if (j == 0) { out_re[(size_t)n * 4096 + gp] = carry.x; out_im[(size_t)n * 4096 + gp] = carry.y; }
        f32x2 pw = {1.f, 0.f}; f32x2* o = CIN + ((size_t)(n * 128 + 16 * j)) * 4096 + gp;
#pragma unroll
        for (int k = 0; k < 16; ++k) { o[(size_t)k * 4096] = f32x2{loc[k].x + pw.x * mine.x - pw.y * mine.y, loc[k].y + pw.x * mine.y + pw.y * mine.x}; pw = f32x2{pw.x * A.x - pw.y * A.y, pw.x * A.y + pw.y * A.x}; }
    }
}
#undef SSM_LOAD
}
namespace sg {
constexpr size_t WS_SSS = WS_SSM + 34 * MiB;
constexpr size_t WS_QKVS = WS_SSS + 65536;
enum { M_QKV = 0, M_RES = 1, M_GLU = 2, M_UP = 3 };
struct P { float* x; bf16* xb; float* sss; float* qkvs; bf16* act; const float* cw; const float* cb; const float* stc; float* cso; };
__device__ __forceinline__ float rs_of(const float* sss, int t) { const f32x4* p = (const f32x4*)(sss + t * 64); float s = 0.f;
#pragma unroll
    for (int i = 0; i < 16; ++i) { const f32x4 v = p[i]; s += (v[0] + v[1]) + (v[2] + v[3]); }
    return 1.0f / sqrtf(s * (1.0f / 1024.0f) + 1e-6f); }
__device__ __forceinline__ float rs_of4(const float* sss, int t, int kq) { const f32x4* p = (const f32x4*)(sss + t * 64 + 16 * kq); float s = 0.f;
#pragma unroll
    for (int i = 0; i < 4; ++i) { const f32x4 v = p[i]; s += (v[0] + v[1]) + (v[2] + v[3]); }
    s += __shfl_xor(s, 16); s += __shfl_xor(s, 32);
    return 1.0f / sqrtf(s * (1.0f / 1024.0f) + 1e-6f); }
template <int MODE, int KK, int NT>
__device__ __forceinline__ void unit(int uu, const bf16* __restrict__ Xs, const bf16* __restrict__ Wt, const P p, LAS unsigned char* L) {
    constexpr bool PAIRED = (MODE == M_GLU || MODE == M_UP);
    constexpr int NTG = 8 / NT, NKS = KK / 256;
    const int u = uu / NTG, tg = uu % NTG;
    const int tid = opaque_tid(), lane = tid & 63, i16 = lane & 15, kq = lane >> 4; const int wave = __builtin_amdgcn_readfirstlane(tid >> 6);
    const int rA = PAIRED ? (256 * (u >> 3) + 16 * (u & 7)) : 16 * u;
    const bf16* wa = Wt + (size_t)(rA + i16) * KK + wave * (KK / 8) + 8 * kq;
    const bf16* xa = Xs + (size_t)(16 * NT * tg + i16) * KK + wave * (KK / 8) + 8 * kq;
    const int tE = 16 * (NT * tg + (wave < NT ? wave : 0)) + i16;
    const int cE = MODE == M_RES ? 256 * (u >> 4) + 128 * ((u >> 3) & 1) + 32 * ((u >> 1) & 3) + 4 * (u & 1) + 8 * kq : 128 * (u >> 3) + 32 * ((u & 7) >> 1) + 4 * (u & 1) + 8 * kq;
    f32x4 pre0 = (f32x4){0.f, 0.f, 0.f, 0.f}, pre1 = pre0, pre2 = pre0, pre3 = pre0; float preR = 0.f;
    f32x4 tg0 = pre0, tg1 = pre0, tg2 = pre0, tgb = pre0, tv0 = pre0, tv1 = pre0, tv2 = pre0, tvb = pre0;
    if (wave < NT) {
        if (MODE == M_RES || MODE == M_GLU) pre0 = *(const f32x4*)(p.x + (size_t)tE * 1024 + cE);
        if (MODE == M_UP) { const float* s0 = p.stc + (size_t)tE * 2 * 5632;
            tg0 = *(const f32x4*)(p.cw + cE); tg1 = *(const f32x4*)(p.cw + 5632 + cE); tg2 = *(const f32x4*)(p.cw + 2 * 5632 + cE); tgb = *(const f32x4*)(p.cb + cE);
            tv0 = *(const f32x4*)(p.cw + 2816 + cE); tv1 = *(const f32x4*)(p.cw + 5632 + 2816 + cE); tv2 = *(const f32x4*)(p.cw + 2 * 5632 + 2816 + cE); tvb = *(const f32x4*)(p.cb + 2816 + cE);
            pre0 = __builtin_nontemporal_load((const f32x4*)(s0 + cE)); pre1 = __builtin_nontemporal_load((const f32x4*)(s0 + 5632 + cE)); pre2 = __builtin_nontemporal_load((const f32x4*)(s0 + 2816 + cE)); pre3 = __builtin_nontemporal_load((const f32x4*)(s0 + 5632 + 2816 + cE)); preR = rs_of4(p.sss, tE, kq); }
    }
    f32x4 acc[NT], accB[NT];
#pragma unroll
    for (int m = 0; m < NT; ++m) { acc[m] = (f32x4){0.f, 0.f, 0.f, 0.f}; accB[m] = (f32x4){0.f, 0.f, 0.f, 0.f}; }
    bf16x8 wf[NKS], wg[NKS];
#pragma unroll
    for (int ks = 0; ks < NKS; ++ks) { wf[ks] = *(const bf16x8*)(wa + 32 * ks); if (PAIRED) wg[ks] = *(const bf16x8*)(wa + (size_t)128 * KK + 32 * ks); }
    constexpr int MB = (NKS <= 4) ? (NT >= 4 ? 4 : NT) : (NT * NKS <= 24 ? NT : 1);
#pragma unroll
    for (int m0 = 0; m0 < NT; m0 += MB) {
        bf16x8 xf[MB][NKS];
#pragma unroll
        for (int mm = 0; mm < MB; ++mm)
#pragma unroll
            for (int ks = 0; ks < NKS; ++ks) xf[mm][ks] = *(const bf16x8*)(xa + (size_t)(16 * (m0 + mm)) * KK + 32 * ks);
#pragma unroll
        for (int mm = 0; mm < MB; ++mm)
#pragma unroll
            for (int ks = 0; ks < NKS; ++ks) { acc[m0 + mm] = __builtin_amdgcn_mfma_f32_16x16x32_bf16(wf[ks], xf[mm][ks], acc[m0 + mm], 0, 0, 0);
                if (PAIRED) accB[m0 + mm] = __builtin_amdgcn_mfma_f32_16x16x32_bf16(wg[ks], xf[mm][ks], accB[m0 + mm], 0, 0, 0); }
    }
    LAS f32x4* red = (LAS f32x4*)L;
#pragma unroll
    for (int m = 0; m < NT; ++m) { red[(wave * NT + m) * 64 + lane] = acc[m]; if (PAIRED) red[4096 + (wave * NT + m) * 64 + lane] = accB[m]; }
    __syncthreads();
    if (wave < NT) {
    f32x4 ta = (f32x4){0.f, 0.f, 0.f, 0.f}, tb = (f32x4){0.f, 0.f, 0.f, 0.f};
#pragma unroll
    for (int v = 0; v < 8; ++v) { ta += red[(v * NT + wave) * 64 + lane]; if (PAIRED) tb += red[4096 + (v * NT + wave) * 64 + lane]; }
    const int t = 16 * (NT * tg + wave) + i16;
    if (MODE == M_QKV) {
        const int n0 = 256 * (u >> 4) + 64 * ((u >> 1) & 3) + 32 * ((u >> 3) & 1) + 4 * (u & 1) + 8 * kq;
        *(f32x4*)(p.qkvs + (size_t)t * 1536 + n0) = ta * rs_of4(p.sss, t, kq);
    } else if (MODE == M_RES || MODE == M_GLU) {
        const int c = (MODE == M_RES ? 256 * (u >> 4) + 128 * ((u >> 3) & 1) + 32 * ((u >> 1) & 3) + 4 * (u & 1) : 128 * (u >> 3) + 32 * ((u & 7) >> 1) + 4 * (u & 1)) + 8 * kq;
        float* xr = p.x + (size_t)t * 1024 + c; f32x4 o = pre0;
        if (MODE == M_RES) o += ta;
        else {
#pragma unroll
            for (int e = 0; e < 4; ++e) o[e] += ta[e] * __builtin_amdgcn_rcpf(1.0f + __builtin_amdgcn_exp2f(-LOG2E * tb[e])); }
        *(f32x4*)xr = o; v2u w; w.x = pk2(o[0], o[1]); w.y = pk2(o[2], o[3]); *(v2u*)(p.xb + (size_t)t * 1024 + c) = w;
        float s = (o[0] * o[0] + o[1] * o[1]) + (o[2] * o[2] + o[3] * o[3]); s += __shfl_xor(s, 16); s += __shfl_xor(s, 32);
        if (kq == 0) p.sss[t * 64 + u] = s;
    } else {
        const int j = 128 * (u >> 3) + 32 * ((u & 7) >> 1) + 4 * (u & 1) + 8 * kq;
        const float r = preR;
        const f32x4 ug = ta * r, uv = tb * r;
        const float* s0 = p.stc + (size_t)t * 2 * 5632; float* so = p.cso + (size_t)t * 2 * 5632;
        const f32x4 b0g = pre0, b1g = pre1, b0v = pre2, b1v = pre3;
        const f32x4 cg = tgb + tg0 * b0g + tg1 * b1g + tg2 * ug;
        const f32x4 cv = tvb + tv0 * b0v + tv1 * b1v + tv2 * uv;
        f32x4 o;
#pragma unroll
        for (int e = 0; e < 4; ++e) o[e] = cg[e] * __builtin_amdgcn_rcpf(1.0f + __builtin_amdgcn_exp2f(-LOG2E * cg[e])) * cv[e];
        v2u w; w.x = pk2(o[0], o[1]); w.y = pk2(o[2], o[3]); *(v2u*)(p.act + (size_t)t * 2816 + j) = w;
        __builtin_nontemporal_store(b1g, (f32x4*)(so + j)); __builtin_nontemporal_store(b1v, (f32x4*)(so + 2816 + j)); __builtin_nontemporal_store(ug, (f32x4*)(so + 5632 + j)); __builtin_nontemporal_store(uv, (f32x4*)(so + 5632 + 2816 + j));
    }
    }
    __syncthreads();
}

__device__ __forceinline__ void attn_pairs(int pid0, const float* __restrict__ qkvs, const float* __restrict__ ck, const float* __restrict__ cv, const float* __restrict__ qg, const float* __restrict__ kg,
                                           const float* __restrict__ sink, bf16* __restrict__ o, float* __restrict__ kso, float* __restrict__ vso, LAS unsigned char* L) {
    const int tid = opaque_tid(), lane = tid & 63; const int wave = __builtin_amdgcn_readfirstlane(tid >> 6);
    const int slot = wave >> 2, g = wave & 3, pid = pid0 + slot, n = pid >> 2, kv = pid & 3, h = kv * 4 + g;
    const int kk = lane >> 2, dq = lane & 3;
    LAS unsigned char* Kl = L + slot * 65536; LAS unsigned char* Vl = Kl + 32768;
    { const unsigned kb = (unsigned)(uintptr_t)Kl + (32 * g) * 256, vb = (unsigned)(uintptr_t)Vl + (32 * g) * 256;
#pragma unroll
      for (int i = 0; i < 8; ++i) { int r = 32 * g + 4 * i + (lane >> 4); r = r < 127 ? r + 1 : 127;
          const size_t off = ((size_t)(n * 128 + r) * 4 + kv) * 64 + (lane & 15) * 4;
          att::glds16_nt(ck + off, (unsigned)__builtin_amdgcn_readfirstlane(kb + i * 1024)); att::glds16_nt(cv + off, (unsigned)__builtin_amdgcn_readfirstlane(vb + i * 1024)); } }
    const float* row = qkvs + (size_t)n * 1536;
    f32x4 q[4], kn[4], vn[4]; float sq = 0.f, sk = 0.f;
#pragma unroll
    for (int i = 0; i < 4; ++i) { q[i] = *(const f32x4*)(row + h * 64 + 16 * dq + 4 * i); kn[i] = *(const f32x4*)(row + 1024 + kv * 64 + 16 * dq + 4 * i); vn[i] = *(const f32x4*)(row + 1280 + kv * 64 + 16 * dq + 4 * i);
        sq += (q[i][0] * q[i][0] + q[i][1] * q[i][1]) + (q[i][2] * q[i][2] + q[i][3] * q[i][3]); sk += (kn[i][0] * kn[i][0] + kn[i][1] * kn[i][1]) + (kn[i][2] * kn[i][2] + kn[i][3] * kn[i][3]); }
    sq += __shfl_xor(sq, 1); sq += __shfl_xor(sq, 2); sk += __shfl_xor(sk, 1); sk += __shfl_xor(sk, 2);
    const float rq = (1.0f / sqrtf(sq * (1.0f / 64.0f) + 1e-6f)) * QSCALE, rk = 1.0f / sqrtf(sk * (1.0f / 64.0f) + 1e-6f);
#pragma unroll
    for (int i = 0; i < 4; ++i) { q[i] = q[i] * rq * *(const f32x4*)(qg + 16 * dq + 4 * i); kn[i] = kn[i] * rk * *(const f32x4*)(kg + 16 * dq + 4 * i); }
    asm volatile("s_waitcnt vmcnt(0)" ::: "memory");
    if (g == 3 && kk == 0) {
#pragma unroll
        for (int i = 0; i < 4; ++i) { *(LAS f32x4*)(Kl + 127 * 256 + dq * 64 + i * 16) = kn[i]; *(LAS f32x4*)(Vl + 127 * 256 + dq * 64 + i * 16) = vn[i]; } }
    asm volatile("s_waitcnt lgkmcnt(0)\n\ts_barrier" ::: "memory");
    float sc[8];
#pragma unroll
    for (int ps = 0; ps < 8; ++ps) { const LAS unsigned char* kr = Kl + (16 * ps + kk) * 256 + dq * 64; float a = 0.f;
#pragma unroll
        for (int i = 0; i < 4; ++i) { const f32x4 kf = *(const LAS f32x4*)(kr + i * 16); a += (q[i][0] * kf[0] + q[i][1] * kf[1]) + (q[i][2] * kf[2] + q[i][3] * kf[3]); }
        a += __shfl_xor(a, 1); a += __shfl_xor(a, 2); sc[ps] = a; }
    const float sk2 = sink[h] * LOG2E;
    float mx = sk2;
#pragma unroll
    for (int ps = 0; ps < 8; ++ps) mx = fmaxf(mx, sc[ps]);
#pragma unroll
    for (int of = 4; of < 64; of <<= 1) mx = fmaxf(mx, __shfl_xor(mx, of));
    float ls = 0.f;
#pragma unroll
    for (int ps = 0; ps < 8; ++ps) { sc[ps] = __builtin_amdgcn_exp2f(sc[ps] - mx); ls += sc[ps]; }
#pragma unroll
    for (int of = 4; of < 64; of <<= 1) ls += __shfl_xor(ls, of);
    ls += __builtin_amdgcn_exp2f(sk2 - mx);
    f32x4 acc[4];
#pragma unroll
    for (int i = 0; i < 4; ++i) acc[i] = (f32x4){0.f, 0.f, 0.f, 0.f};
#pragma unroll
    for (int ps = 0; ps < 8; ++ps) { const LAS unsigned char* vr = Vl + (16 * ps + kk) * 256 + dq * 64;
#pragma unroll
        for (int i = 0; i < 4; ++i) acc[i] += *(const LAS f32x4*)(vr + i * 16) * sc[ps]; }
    const float inv = 1.0f / ls;
#pragma unroll
    for (int i = 0; i < 4; ++i)
#pragma unroll
        for (int e = 0; e < 4; ++e) { float v = acc[i][e]; v += __shfl_xor(v, 4); v += __shfl_xor(v, 8); v += __shfl_xor(v, 16); v += __shfl_xor(v, 32); acc[i][e] = v * inv; }
    if (kk == 0) {
#pragma unroll
        for (int i = 0; i < 4; ++i) { v2u w; w.x = pk2(acc[i][0], acc[i][1]); w.y = pk2(acc[i][2], acc[i][3]); *(v2u*)(o + (size_t)n * 1024 + h * 64 + 16 * dq + 4 * i) = w; }
    }
    if (g == 3 && kk == 0) { const size_t off = ((size_t)(n * 128 + 127) * 4 + kv) * 64 + 16 * dq;
#pragma unroll
        for (int i = 0; i < 4; ++i) { *(f32x4*)(kso + off + 4 * i) = kn[i]; *(f32x4*)(vso + off + 4 * i) = vn[i]; } }
    asm volatile("s_waitcnt lgkmcnt(0)\n\ts_barrier" ::: "memory");
}

__device__ __forceinline__ void ssm_step2(const int (&n)[2], const int (&g)[2], const ssm::Tab T, const float* __restrict__ x, const float* __restrict__ sss, const float* __restrict__ h0r, const float* __restrict__ h0i,
                                          bf16* __restrict__ z, float* __restrict__ out_re, float* __restrict__ out_im, LAS f32x2* xs, int lane) {
    const int c = lane & 15, pq = lane >> 4;
    float r[2], uc[2], dgc[2], nr[2], ni[2]; bf16x8 cr0[2], cr1[2], ci0[2], ci1[2];
#pragma unroll
    for (int k = 0; k < 2; ++k) {
        r[k] = rs_of(sss, n[k]);
        const float* xr = x + (size_t)n[k] * 1024 + g[k] * 16;
        float u[16];
#pragma unroll
        for (int i = 0; i < 4; ++i) { const f32x4 v = *(const f32x4*)(xr + 4 * i); u[4 * i] = v[0]; u[4 * i + 1] = v[1]; u[4 * i + 2] = v[2]; u[4 * i + 3] = v[3]; }
        const bf16x8* br = (const bf16x8*)(T.bbt + ((size_t)g[k] * 128 + lane) * 16); const bf16x8* bi = (const bf16x8*)(T.bbt + ((size_t)g[k] * 128 + 64 + lane) * 16);
        const bf16x8* cr = (const bf16x8*)(T.cct + ((size_t)g[k] * 16 + c) * 128 + 16 * pq); const bf16x8* ci = (const bf16x8*)(T.cct + ((size_t)g[k] * 16 + c) * 128 + 64 + 16 * pq);
        cr0[k] = cr[0]; cr1[k] = cr[1]; ci0[k] = ci[0]; ci1[k] = ci[1];
        uc[k] = xr[c]; dgc[k] = T.dg[g[k] * 16 + c];
        float bur = 0.f, bui = 0.f;
#pragma unroll
        for (int hh = 0; hh < 2; ++hh) { const bf16x8 a = br[hh], b = bi[hh];
#pragma unroll
            for (int e = 0; e < 8; ++e) { bur += u[8 * hh + e] * bf2f((unsigned short)a[e]); bui += u[8 * hh + e] * bf2f((unsigned short)b[e]); } }
        const f32x2 A = *(const f32x2*)(T.ab + 2 * (g[k] * 64 + lane));
        const size_t si = ((size_t)n[k] * 64 + g[k]) * 64 + lane;
        const float sr = h0r[si], sim = h0i[si];
        nr[k] = A.x * sr - A.y * sim + r[k] * bur; ni[k] = A.x * sim + A.y * sr + r[k] * bui;
        out_re[si] = nr[k]; out_im[si] = ni[k];
        xs[64 * k + lane] = f32x2{nr[k], ni[k]};
    }
    LDS_WAIT(); asm volatile("" ::: "memory");
#pragma unroll
    for (int k = 0; k < 2; ++k) {
        float y = 0.f;
#pragma unroll
        for (int q2 = 0; q2 < 8; ++q2) { const f32x4 q = *(const LAS f32x4*)(xs + 64 * k + 16 * pq + 2 * q2);
            const int e0 = 2 * q2, e1 = 2 * q2 + 1;
            const float c0r = bf2f((unsigned short)(e0 < 8 ? cr0[k][e0] : cr1[k][e0 - 8])), c0i = bf2f((unsigned short)(e0 < 8 ? ci0[k][e0] : ci1[k][e0 - 8]));
            const float c1r = bf2f((unsigned short)(e1 < 8 ? cr0[k][e1] : cr1[k][e1 - 8])), c1i = bf2f((unsigned short)(e1 < 8 ? ci0[k][e1] : ci1[k][e1 - 8]));
            y += q[0] * c0r + q[1] * c0i + q[2] * c1r + q[3] * c1i; }
        y += __shfl_xor(y, 16); y += __shfl_xor(y, 32);
        if (lane < 16) {
            const float yy = y + dgc[k] * r[k] * uc[k];
            const float u2 = 1.5957691216057308f * (yy + 0.044715f * yy * yy * yy);
            z[(size_t)n[k] * 1024 + g[k] * 16 + lane] = (bf16)f2bf(yy * __builtin_amdgcn_rcpf(1.0f + __builtin_amdgcn_exp2f(-LOG2E * u2)));
        }
    }
    LDS_WAIT(); asm volatile("" ::: "memory");
}
}
#define XB_TMO      128
#define XB_XCNT(j)  (256  + 64 * (j))
#define XB_XSUB(j)  (1280 + 64 * (j))
#define XB_XGEN(j)  (2304 + 64 * (j))
#define XB_TOP      3328
#define XB_TOPGEN   3392
#define XCD_BAR_WORDS 3456
#define XB_SPIN_CAP (1u << 18)

__device__ __forceinline__ unsigned xb_ld(unsigned* p)              { return __hip_atomic_load(p, __ATOMIC_RELAXED, __HIP_MEMORY_SCOPE_AGENT); }
__device__ __forceinline__ unsigned xb_add(unsigned* p, unsigned v) { return __hip_atomic_fetch_add(p, v, __ATOMIC_RELAXED, __HIP_MEMORY_SCOPE_AGENT); }
__device__ __forceinline__ unsigned xb_xcc_id() { return (unsigned)__builtin_amdgcn_s_getreg((3 << 11) | 20) & 0xFu; }
#define XB_SPIN(cond, bar) do { unsigned _sp = 0; while (cond) { __builtin_amdgcn_s_sleep(1); \
    if ((++_sp & 255u) == 0u) { if (xb_ld(&(bar)[XB_TMO])) break; if (_sp > XB_SPIN_CAP) { atomicAdd(&(bar)[XB_TMO], 1u); break; } } } } while (0)

struct XcdBarrier {
    unsigned* bar; unsigned x;
    volatile LAS unsigned* st;
};

__device__ __forceinline__ XcdBarrier xcd_barrier_post(unsigned* bar, volatile LAS unsigned* st) {
    XcdBarrier b; b.bar = bar; b.x = xb_xcc_id(); b.st = st;
    if (threadIdx.x == 0) (void)xb_add(&bar[XB_XCNT(b.x)], 1u);
    return b;
}
__device__ __forceinline__ void xcd_barrier_complete(unsigned* bar, unsigned x, unsigned& nloc, unsigned& nx) {
    const unsigned G = gridDim.x * gridDim.y * gridDim.z;
    unsigned sum, cnt, mine, sp = 0u;
    for (;;) {
        sum = 0u; cnt = 0u; mine = 0u;
#pragma unroll
        for (unsigned j = 0; j < 16; ++j) { const unsigned c = xb_ld(&bar[XB_XCNT(j)]); sum += c; cnt += (c > 0u) ? 1u : 0u; mine = (j == x) ? c : mine; }
        if (sum == G) break;
        __builtin_amdgcn_s_sleep(1);
        if ((++sp & 255u) == 0u) { if (xb_ld(&bar[XB_TMO])) break; if (sp > XB_SPIN_CAP) { atomicAdd(&bar[XB_TMO], 1u); break; } }
    }
    nloc = mine > 0u ? mine : 1u; nx = cnt > 0u ? cnt : 1u;
}

__device__ __forceinline__ void xcd_barrier(const XcdBarrier& b) {
    asm volatile("s_waitcnt vmcnt(0)" ::: "memory");
    __syncthreads();
    if (threadIdx.x == 0) {
        unsigned* bar = b.bar;
        __builtin_amdgcn_s_waitcnt(0);
        unsigned nloc = b.st[0], nx = b.st[1];
        if (nloc == 0u) { xcd_barrier_complete(bar, b.x, nloc, nx); b.st[0] = nloc; b.st[1] = nx; }
        const unsigned old = xb_add(&bar[XB_XSUB(b.x)], 1u);
        const unsigned gen = old / nloc;
        if (old + 1u == (gen + 1u) * nloc) {
            __builtin_amdgcn_fence(__ATOMIC_RELEASE, "agent");
            asm volatile("s_waitcnt vmcnt(0)" ::: "memory");
            const unsigned og = xb_add(&bar[XB_TOP], 1u);
            const unsigned tg = og / nx;
            if (og + 1u == (tg + 1u) * nx) xb_add(&bar[XB_TOPGEN], 1u);
            else XB_SPIN(xb_ld(&bar[XB_TOPGEN]) == tg, bar);
            __builtin_amdgcn_fence(__ATOMIC_ACQUIRE, "agent");
            xb_add(&bar[XB_XGEN(b.x)], 1u);
            asm volatile("s_waitcnt vmcnt(0)" ::: "memory");
        } else {
            XB_SPIN(xb_ld(&bar[XB_XGEN(b.x)]) == gen, bar);
            __builtin_amdgcn_fence(__ATOMIC_ACQUIRE, "agent");
            asm volatile("s_waitcnt vmcnt(0)" ::: "memory");
        }
    }
    __syncthreads();
}


constexpr int NWAVES = 8;
constexpr int RING_BYTES = 131072;
constexpr int LDS_BYTES = 163840;
constexpr int LDSCTL_OFF = LDS_BYTES - 1024, MISC_OFF = LDSCTL_OFF + 320;
static_assert(8 * ssm::WREG <= LDSCTL_OFF && RING_BYTES <= LDSCTL_OFF, "LDS map");
enum Kind { K_PRO = 0, K_QKV, K_ATT, K_WO, K_S1, K_S2, K_S3, K_GLU, K_UP, K_DN };
constexpr int N_PHASES = 23;
__host__ __device__ __forceinline__ void phase_decode(int ph, int& layer, int& kind) {
    if (ph == 0) { layer = 0; kind = K_PRO; return; }
    const int q = ph - 1, pair = q / 11, r = q % 11;
    if (r < 5) { layer = 2 * pair; kind = r == 0 ? K_QKV : r == 1 ? K_ATT : r == 2 ? K_WO : r == 3 ? K_UP : K_DN; }
    else { layer = 2 * pair + 1; const int s = r - 5; kind = s == 0 ? K_S1 : s == 1 ? K_S2 : s == 2 ? K_S3 : s == 3 ? K_GLU : s == 4 ? K_UP : K_DN; }
}

struct Args {
    const float* in[27]; float* out; unsigned char* ws; int ph_lo, ph_hi, li, pad;
};

struct RM_ID  { __device__ __forceinline__ int operator()(int n) const { return n; } };
struct RM_QKV { __device__ __forceinline__ int operator()(int n) const { const int pn = n >> 8, l = n & 255, wc = l >> 6, d = l & 63, bj = d >> 5, fq = (d >> 3) & 3, nn = (d >> 2) & 1, e = d & 3; return (pn << 8) + 128 * bj + 32 * wc + 16 * nn + 4 * fq + e; } };
struct RM_GLU { __device__ __forceinline__ int operator()(int n) const { const int half = n >> 10, c = n & 1023, l = c & 127, wc = l >> 5, fq = (l >> 3) & 3, nn = (l >> 2) & 1, e = l & 3; return ((c >> 7) << 8) + 128 * half + 32 * wc + 16 * nn + 4 * fq + e; } };
struct RM_RES { __device__ __forceinline__ int operator()(int n) const { const int l = n & 31, fq = (l >> 3) & 3, nn = (l >> 2) & 1, e = l & 3; return (n & ~31) + 16 * nn + 4 * fq + e; } };
struct RM_UP  { __device__ __forceinline__ int operator()(int n) const { const int half = n >= 2816 ? 1 : 0, j = n - 2816 * half, pn = j >> 7, l = j & 127, wc = l >> 5, fq = (l >> 3) & 3, nn = (l >> 2) & 1, e = l & 3; return (pn << 8) + 128 * half + 32 * wc + 16 * nn + 4 * fq + e; } };

template <class RM>
__device__ __forceinline__ void transpose_item(const float* __restrict__ W, int K, int N, bf16* __restrict__ WT, const float* __restrict__ gain, LAS float* scr, int item, int lane, RM rm) {
    const int nblk = N / 32, kb = item / nblk, nb = item % nblk, k0 = 64 * kb, n0 = 32 * nb;
    const int kr = lane >> 3, n4 = (lane & 7) * 4;
    f32x4 v[8];
#pragma unroll
    for (int i = 0; i < 8; ++i) v[i] = __builtin_nontemporal_load((const f32x4*)(W + (size_t)(k0 + 8 * i + kr) * N + n0 + n4));
#pragma unroll
    for (int i = 0; i < 8; ++i) { const float gk = gain ? gain[k0 + 8 * i + kr] : 1.0f; *(LAS f32x4*)(scr + (8 * i + kr) * 36 + n4) = v[i] * gk; }
    LDS_WAIT(); asm volatile("" ::: "memory");
    const int c = lane & 7;
#pragma unroll
    for (int j = 0; j < 4; ++j) { const int n = (lane >> 3) + 8 * j; const LAS float* s = scr + (8 * c) * 36 + n;
        v4u o; o.x = pk2(s[0 * 36], s[1 * 36]); o.y = pk2(s[2 * 36], s[3 * 36]); o.z = pk2(s[4 * 36], s[5 * 36]); o.w = pk2(s[6 * 36], s[7 * 36]);
        __builtin_nontemporal_store(o, (GAS v4u*)(WT + (size_t)rm(n0 + n) * K + k0 + 8 * c)); }
    LDS_WAIT(); asm volatile("" ::: "memory");
}
__device__ __forceinline__ void x_row_init(const float* __restrict__ src, float* xdst, bf16* __restrict__ xb, float* __restrict__ ssr, int nslots, int lane) {
    const GAS f32x4* xr = (const GAS f32x4*)src + lane; f32x4 v[4]; float s = 0.f;
#pragma unroll
    for (int j = 0; j < 4; ++j) { v[j] = xr[64 * j]; s += (v[j].x * v[j].x + v[j].y * v[j].y) + (v[j].z * v[j].z + v[j].w * v[j].w); }
    s = wave_sum(s);
#pragma unroll
    for (int j = 0; j < 4; ++j) { if (xdst) ((GAS f32x4*)xdst + lane)[64 * j] = v[j]; ((GAS unsigned long long*)xb + lane)[64 * j] = (unsigned long long)pk2(v[j].x, v[j].y) | ((unsigned long long)pk2(v[j].z, v[j].w) << 32); }
    if (lane < nslots) ssr[lane] = lane == 0 ? s : 0.f;
}

__device__ __forceinline__ void x_rows2_init(const float* __restrict__ s0, const float* __restrict__ s1, bf16* __restrict__ b0, bf16* __restrict__ b1, float* __restrict__ q0, float* __restrict__ q1, int lane) {
    const GAS f32x4* x0 = (const GAS f32x4*)s0 + lane; const GAS f32x4* x1 = (const GAS f32x4*)s1 + lane; f32x4 v[4], w[4]; float sa = 0.f, sb = 0.f;
#pragma unroll
    for (int j = 0; j < 4; ++j) { v[j] = __builtin_nontemporal_load(x0 + 64 * j); w[j] = __builtin_nontemporal_load(x1 + 64 * j); }
#pragma unroll
    for (int j = 0; j < 4; ++j) { sa += (v[j].x * v[j].x + v[j].y * v[j].y) + (v[j].z * v[j].z + v[j].w * v[j].w); sb += (w[j].x * w[j].x + w[j].y * w[j].y) + (w[j].z * w[j].z + w[j].w * w[j].w); }
    sa = wave_sum(sa); sb = wave_sum(sb);
#pragma unroll
    for (int j = 0; j < 4; ++j) { __builtin_nontemporal_store((unsigned long long)pk2(v[j].x, v[j].y) | ((unsigned long long)pk2(v[j].z, v[j].w) << 32), (GAS unsigned long long*)b0 + lane + 64 * j);
                                  __builtin_nontemporal_store((unsigned long long)pk2(w[j].x, w[j].y) | ((unsigned long long)pk2(w[j].z, w[j].w) << 32), (GAS unsigned long long*)b1 + lane + 64 * j); }
    if (lane < 16) { q0[lane] = lane == 0 ? sa : 0.f; q1[lane] = lane == 0 ? sb : 0.f; }
}

__device__ __forceinline__ void ffn_fixup(int pm, bool write_conv, const float* __restrict__ halo, const float* __restrict__ cw, const float* __restrict__ cb, bf16* __restrict__ act, float* __restrict__ conv_out) {
    const int tid = opaque_tid();
    for (int j = 4 * tid; j < 2816; j += 4 * 512) {
        f32x4 w0[2], w1[2], w2[2], bb[2];
#pragma unroll
        for (int hf = 0; hf < 2; ++hf) { const int c = j + 2816 * hf; w0[hf] = *(const f32x4*)(cw + c); w1[hf] = *(const f32x4*)(cw + 5632 + c); w2[hf] = *(const f32x4*)(cw + 2 * 5632 + c); bb[hf] = *(const f32x4*)(cb + c); }
        f32x4 H0[2][2], H1[2][2], P2[2][2], P3[2][2];
#pragma unroll
        for (int b = 0; b < 2; ++b) {
            const int blk = 2 * pm + b; const bool first = (blk & 31) == 0;
            const float* h0 = halo + (size_t)blk * 4 * 5632; const float* hp = halo + (size_t)(first ? blk : blk - 1) * 4 * 5632;
#pragma unroll
            for (int hf = 0; hf < 2; ++hf) { const int c = j + 2816 * hf; H0[b][hf] = *(const f32x4*)(h0 + c); H1[b][hf] = *(const f32x4*)(h0 + 5632 + c);
                P2[b][hf] = *(const f32x4*)(hp + 2 * 5632 + c); P3[b][hf] = *(const f32x4*)(hp + 3 * 5632 + c);
                if (first) { P2[b][hf] = (f32x4){0.f, 0.f, 0.f, 0.f}; P3[b][hf] = (f32x4){0.f, 0.f, 0.f, 0.f}; } }
        }
#pragma unroll
        for (int b = 0; b < 2; ++b) {
            const int blk = 2 * pm + b;
            const f32x4 g0 = bb[0] + w2[0] * H0[b][0] + w1[0] * P3[b][0] + w0[0] * P2[b][0], v0 = bb[1] + w2[1] * H0[b][1] + w1[1] * P3[b][1] + w0[1] * P2[b][1];
            const f32x4 g1 = bb[0] + w2[0] * H1[b][0] + w1[0] * H0[b][0] + w0[0] * P3[b][0], v1 = bb[1] + w2[1] * H1[b][1] + w1[1] * H0[b][1] + w0[1] * P3[b][1];
            f32x4 o0, o1;
#pragma unroll
            for (int e = 0; e < 4; ++e) { o0[e] = g0[e] * __builtin_amdgcn_rcpf(1.0f + __builtin_amdgcn_exp2f(-LOG2E * g0[e])) * v0[e]; o1[e] = g1[e] * __builtin_amdgcn_rcpf(1.0f + __builtin_amdgcn_exp2f(-LOG2E * g1[e])) * v1[e]; }
            v2u q0, q1; q0.x = pk2(o0[0], o0[1]); q0.y = pk2(o0[2], o0[3]); q1.x = pk2(o1[0], o1[1]); q1.y = pk2(o1[2], o1[3]);
            *(v2u*)(act + (size_t)(128 * blk) * 2816 + j) = q0; *(v2u*)(act + (size_t)(128 * blk + 1) * 2816 + j) = q1;
        }
    }
    if (write_conv && (pm & 15) == 15) {
        const int blk = 2 * pm + 1, n = pm >> 4; const float* h0 = halo + (size_t)blk * 4 * 5632;
        for (int c = 4 * tid; c < 2 * 5632; c += 4 * 512) *(f32x4*)(conv_out + (size_t)n * 2 * 5632 + c) = *(const f32x4*)(h0 + 2 * 5632 + c);
    }
}

constexpr int XL_RS = RING_BYTES, XL_CV = RING_BYTES + 6 * 1024;
static_assert(XL_CV + 6 * 4096 <= LDSCTL_OFF, "spare LDS");
template <bool APERM_UNUSED, bool CONV>
__device__ __forceinline__ void prestage(LAS unsigned char* L, const pg8::StaticOrder& S, const float* __restrict__ ss, int np4, const float* __restrict__ cw, const float* __restrict__ cb) {
    const int tid = opaque_tid(), l8 = tid & 7;
    pg8::Unit u[6]; bool ok[6];
#pragma unroll
    for (int i = 0; i < 6; ++i) ok[i] = S.next(i, u[i]);
    f32x4 rt[6][4], tv[6];
#pragma unroll
    for (int i = 0; i < 6; ++i) {
#pragma unroll
        for (int k = 0; k < 4; ++k) rt[i][k] = (f32x4){0.f, 0.f, 0.f, 0.f};
        tv[i] = (f32x4){0.f, 0.f, 0.f, 0.f};
        if (ok[i]) {
            if (l8 < np4) {
#pragma unroll
                for (int k = 0; k < 4; ++k) rt[i][k] = *(const f32x4*)(ss + (size_t)(u[i].pm * 256 + 64 * k + (tid >> 3)) * 32 + 4 * l8); }
            if (CONV && tid < 256) { const int a = tid >> 5, j = u[i].pn * 128 + 4 * (tid & 31);
                const float* src = (a & 3) == 3 ? cb + j : cw + (size_t)(a & 3) * 5632 + j;
                tv[i] = *(const f32x4*)(src + (a >> 2) * 2816); }
        }
    }
#pragma unroll
    for (int i = 0; i < 6; ++i) if (ok[i]) {
#pragma unroll
        for (int k = 0; k < 4; ++k) { const int row = 64 * k + (tid >> 3);
            float sm = (rt[i][k][0] + rt[i][k][1]) + (rt[i][k][2] + rt[i][k][3]);
            sm += __shfl_xor(sm, 1); sm += __shfl_xor(sm, 2); sm += __shfl_xor(sm, 4);
            if (l8 == 0) ((LAS float*)(L + XL_RS))[i * 256 + row] = __builtin_amdgcn_rsqf(sm * (1.0f / 1024.0f) + 1e-6f); }
        if (CONV && tid < 256) { const int a = tid >> 5; *(LAS f32x4*)(L + XL_CV + i * 4096 + a * 512 + (tid & 31) * 16) = tv[i] * (a < 4 ? -LOG2E : -0.6931471805599453f); }
    }
    __syncthreads();
}

__device__ __forceinline__ void convert_layer(const Args& args, unsigned char* ws, int layer, int gw, int ngw, LAS float* scr, int lane) {
    constexpr int I_QKV = 16 * 48, I_WO = 16 * 32, I_GLU = 16 * 64, I_UP = 16 * 176, I_DN = 44 * 32;
    const int jm = layer >> 1; const bool swa = (layer & 1) == 0;
    const int n_mix = swa ? I_QKV + I_WO : I_GLU, n_all = n_mix + I_UP + I_DN;
    for (int it = gw; it < n_all; it += ngw) {
        int r = it;
        if (r < n_mix) {
            if (swa) { if (r < I_QKV) transpose_item(args.in[9] + (size_t)jm * 1024 * 1536, 1024, 1536, (bf16*)(ws + WS_WQKV) + (size_t)jm * 1536 * 1024, args.in[7] + (size_t)layer * 1024, scr, r, lane, RM_QKV());
                       else transpose_item(args.in[10] + (size_t)jm * 1024 * 1024, 1024, 1024, (bf16*)(ws + WS_WO) + (size_t)jm * 1024 * 1024, nullptr, scr, r - I_QKV, lane, RM_RES()); }
            else transpose_item(args.in[22] + (size_t)jm * 1024 * 2048, 1024, 2048, (bf16*)(ws + WS_WGLU) + (size_t)jm * 2048 * 1024, nullptr, scr, r, lane, RM_GLU());
            continue; }
        r -= n_mix;
        if (r < I_UP) { transpose_item(args.in[23] + (size_t)layer * 1024 * 5632, 1024, 5632, (bf16*)(ws + WS_WUP) + (size_t)layer * 5632 * 1024, args.in[8] + (size_t)layer * 1024, scr, r, lane, RM_UP()); continue; }
        r -= I_UP;
        transpose_item(args.in[26] + (size_t)layer * 2816 * 1024, 2816, 1024, (bf16*)(ws + WS_WDN) + (size_t)layer * 1024 * 2816, nullptr, scr, r, lane, RM_RES());
    }
}

#ifndef ONLY_KIND
#define ONLY_KIND -1
#endif
#define EN(k) (ONLY_KIND < 0 || ONLY_KIND == (k))
#ifndef SAMPLE
#define SAMPLE 1
#endif
__global__ void __launch_bounds__(NWAVES * 64, 2) mega_fwd(Args args) {
    extern __shared__ __attribute__((aligned(16))) unsigned char lds[];
    LAS unsigned char* L = (LAS unsigned char*)lds;
    volatile LAS unsigned* MISC = (volatile LAS unsigned*)(L + MISC_OFF);
    constexpr int G = 256;
    if (gridDim.x != G) __builtin_trap();
    const int bx = blockIdx.x; const int vcu = (G % 8 == 0) ? (bx % 8) * (G / 8) + bx / 8 : bx;
    unsigned char* ws = args.ws;
    gu32* ctl = (gu32*)(ws + WS_CTL);
    float* out = args.out; float* x = out;
    bf16* XB = (bf16*)(ws + WS_XB); float* SS = (float*)(ws + WS_SS);
    bf16* Qb = (bf16*)(ws + WS_Q); bf16* Kb = (bf16*)(ws + WS_K); bf16* Vb = (bf16*)(ws + WS_V); bf16* Ob = (bf16*)(ws + WS_O);
    bf16* ACT = (bf16*)(ws + WS_ACT); float* HALO = (float*)(ws + WS_HALO);
    float* SSS = (float*)(ws + sg::WS_SSS); float* QKVS = (float*)(ws + sg::WS_QKVS);
    for (int u = threadIdx.x; u < (LDS_BYTES - LDSCTL_OFF) / 4; u += NWAVES * 64) ((LAS unsigned*)(L + LDSCTL_OFF))[u] = 0u;
    __syncthreads();
    XcdBarrier bar = xcd_barrier_post((unsigned*)(ctl + CW_BAR) + args.li * XCD_BAR_WORDS, MISC + 8);

    for (int ph = args.ph_lo; ph < args.ph_hi; ++ph) {
        int layer, kind; phase_decode(ph, layer, kind);
        const int tid = opaque_tid(), lane = tid & 63, wave = __builtin_amdgcn_readfirstlane(tid >> 6);
        const int jm = layer >> 1;
        const sg::P sp{x + (size_t)MP * 1024, XB + (size_t)MP * 1024, SSS, QKVS, ACT + (size_t)MP * 2816, args.in[24] + (size_t)layer * 3 * 5632, args.in[25] + (size_t)layer * 5632,
                       args.in[6] + (size_t)layer * DB * 2 * 5632, out + O_CS + (size_t)layer * DB * 2 * 5632};
        const int gwv = vcu * NWAVES + wave;
        if (kind == K_PRO && EN(K_PRO)) {
            LAS float* scr = (LAS float*)(L + wave * 16384);
            const int gw = vcu * NWAVES + wave, NGW = G * NWAVES;
            convert_layer(args, ws, 0, gw, NGW, scr, lane);
            if ((gw & 15) == 0 || G != 256) for (int t = (G == 256 ? (gw >> 4) : gw) * 64 + lane; t < 8192; t += (G == 256 ? NGW / 16 : NGW) * 64) { const int j = t >> 12, gp = t & 4095;
                ssm::build_tables(ws, j, gp, args.in[14] + (size_t)j * 4096, args.in[15] + (size_t)j * 4096, args.in[16] + j * 64, args.in[17] + (size_t)j * 65536, args.in[18] + (size_t)j * 65536,
                                  args.in[19] + (size_t)j * 65536, args.in[20] + (size_t)j * 65536, args.in[21] + (size_t)j * 1024, args.in[7] + (size_t)(2 * j + 1) * 1024); }
            for (int m = gw; m + NGW < MP; m += 2 * NGW) x_rows2_init(args.in[0] + (size_t)m * 1024, args.in[0] + (size_t)(m + NGW) * 1024, XB + (size_t)m * 1024, XB + (size_t)(m + NGW) * 1024, SS + (size_t)m * 32, SS + (size_t)(m + NGW) * 32, lane);
            for (int m = gw; m < DB; m += NGW) x_row_init(args.in[1] + (size_t)m * 1024, x + (size_t)(MP + m) * 1024, XB + (size_t)(MP + m) * 1024, SSS + (size_t)m * 64, 64, lane);
        } else if (kind == K_QKV && EN(K_QKV)) {
            if (SAMPLE) for (int u = G - 1 - bx; u < 96; u += G) sg::unit<sg::M_QKV, 1024, 8>(u, XB + (size_t)MP * 1024, (const bf16*)(ws + WS_WQKV) + (size_t)jm * 1536 * 1024, sp, L);
            pg8::Gemm g{XB, (const bf16*)(ws + WS_WQKV) + (size_t)jm * 1536 * 1024, MP, 1536, 1024}; pg8::StaticOrder S; S.init(MP, 1536, G, bx);
            if (tid < 128) ((LAS float*)(L + XL_CV))[tid] = tid < 64 ? args.in[11][jm * 64 + tid] : args.in[12][jm * 64 + tid - 64];
            prestage<false, false>(L, S, SS, 4, nullptr, nullptr);
            pg8::EpiQKV E{Qb, Kb, Vb, (LAS const float*)(L + XL_RS), (LAS const float*)(L + XL_CV), (LAS const float*)(L + XL_CV) + 64, out + O_KP + (size_t)jm * NB * WIN * 256, out + O_VP + (size_t)jm * NB * WIN * 256};
            pg8::gemm_phase<pg8::EpiQKV, pg8::StaticOrder, true, true, false>(L, g, S, E);
            if (G == 256 && bx >= 128) convert_layer(args, ws, layer + 1, (bx - 128) * NWAVES + wave, 128 * NWAVES, (LAS float*)(L + wave * 16384), lane);
        } else if (kind == K_ATT && EN(K_ATT)) {
            if (!(bx & 8)) {
            if (SAMPLE) for (int pid0 = 2 * vcu; pid0 < 512; pid0 += 2 * G) sg::attn_pairs(pid0, QKVS, args.in[2] + (size_t)jm * DB * WIN * 256, args.in[3] + (size_t)jm * DB * WIN * 256, args.in[11] + jm * 64, args.in[12] + jm * 64,
                                                                                   args.in[13] + jm * 16, Ob + (size_t)MP * 1024, out + O_KS + (size_t)jm * DB * WIN * 256, out + O_VS + (size_t)jm * DB * WIN * 256, L);
            }
            { const att::Roll rl{(const f32x4*)(args.in[2] + (size_t)jm * DB * WIN * 256), (const f32x4*)(args.in[3] + (size_t)jm * DB * WIN * 256), (f32x4*)(out + O_KS + (size_t)jm * DB * WIN * 256), (f32x4*)(out + O_VS + (size_t)jm * DB * WIN * 256)};
              { const int id = vcu * 4; if (id < 1024) att::attn_units4(id >> 8, id & 63, (id >> 6) & 3, Qb, Kb, Vb, Ob, args.in[13] + jm * 16, (LAS char*)L, rl, SAMPLE ? id : -1); } }
            if (bx & 8) {
            if (SAMPLE) for (int pid0 = 2 * vcu; pid0 < 512; pid0 += 2 * G) sg::attn_pairs(pid0, QKVS, args.in[2] + (size_t)jm * DB * WIN * 256, args.in[3] + (size_t)jm * DB * WIN * 256, args.in[11] + jm * 64, args.in[12] + jm * 64,
                                                                                   args.in[13] + jm * 16, Ob + (size_t)MP * 1024, out + O_KS + (size_t)jm * DB * WIN * 256, out + O_VS + (size_t)jm * DB * WIN * 256, L);
            }
        } else if (kind == K_WO && EN(K_WO)) {
            if (SAMPLE) for (int u = G - 1 - bx; u < 256; u += G) sg::unit<sg::M_RES, 1024, 2>(u, Ob + (size_t)MP * 1024, (const bf16*)(ws + WS_WO) + (size_t)jm * 1024 * 1024, sp, L);
            pg8::Gemm g{Ob, (const bf16*)(ws + WS_WO) + (size_t)jm * 1024 * 1024, MP, 1024, 1024}; pg8::StaticOrder S; S.init(MP, 1024, G, bx);
            pg8::EpiRes E{nullptr, XB, SS};
            pg8::gemm_phase<pg8::EpiRes, pg8::StaticOrder, true, true, false>(L, g, S, E);
        } else if (kind == K_S1 && EN(K_S1)) {
            if (SAMPLE) for (int pr = gwv; pr < 4096; pr += G * NWAVES) { const int nn[2] = {pr >> 6, (pr + 4096) >> 6}, gg[2] = {pr & 63, pr & 63};
                sg::ssm_step2(nn, gg, ssm::tab_of(ws, jm), x + (size_t)MP * 1024, SSS, args.in[4] + (size_t)jm * DB * 4096, args.in[5] + (size_t)jm * DB * 4096,
                              Ob + (size_t)MP * 1024, out + O_SRS + (size_t)jm * DB * 4096, out + O_SIS + (size_t)jm * DB * 4096, (LAS f32x2*)(L + wave * ssm::WREG), lane); }
            for (int id = vcu; id < 256; id += G) ssm::unit<false>(id >> 6, id & 63, ssm::tab_of(ws, jm), XB, SS, (f32x2*)(ws + WS_SSM + 2 * MiB), Ob, L);
        } else if (kind == K_S2 && EN(K_S2)) {
            ssm::carries(vcu, G, ssm::tab_of(ws, jm), (const f32x2*)(ws + WS_SSM + 2 * MiB), (f32x2*)(ws + WS_SSM + 18 * MiB), out + O_SRP + (size_t)jm * NB * 4096, out + O_SIP + (size_t)jm * NB * 4096);
            if (layer + 1 < DEPTH) convert_layer(args, ws, layer + 1, vcu * NWAVES + wave, G * NWAVES, (LAS float*)(L + wave * 16384), lane);
        } else if (kind == K_S3 && EN(K_S3)) {
            for (int id = vcu; id < 256; id += G) ssm::unit<true>(id >> 6, id & 63, ssm::tab_of(ws, jm), XB, SS, (f32x2*)(ws + WS_SSM + 18 * MiB), Ob, L);
        } else if (kind == K_GLU && EN(K_GLU)) {
            if (SAMPLE) for (int u = G - 1 - bx; u < 256; u += G) sg::unit<sg::M_GLU, 1024, 2>(u, Ob + (size_t)MP * 1024, (const bf16*)(ws + WS_WGLU) + (size_t)jm * 2048 * 1024, sp, L);
            pg8::Gemm g{Ob, (const bf16*)(ws + WS_WGLU) + (size_t)jm * 2048 * 1024, MP, 2048, 1024}; pg8::StaticOrder S; S.init(MP, 2048, G, bx);
            pg8::EpiGlu E{XB, SS};
            pg8::gemm_phase<pg8::EpiGlu, pg8::StaticOrder, true, true, false>(L, g, S, E);
        } else if (kind == K_UP && EN(K_UP)) {
            if (SAMPLE) {
                const bool slack = G == 256;
                for (int k = 0; k < 3; ++k) { const int u = slack ? (bx >= 128 ? (bx - 128) + 128 * k : 352) : (k < 2 ? (G - 1 - bx) + 256 * k : 352);
                    if (u < 352) sg::unit<sg::M_UP, 1024, 4>(u, XB + (size_t)MP * 1024, (const bf16*)(ws + WS_WUP) + (size_t)layer * 5632 * 1024, sp, L); }
            }
            pg8::Gemm g{XB, (const bf16*)(ws + WS_WUP) + (size_t)layer * 5632 * 1024, MP, 5632, 1024}; pg8::StaticOrder S; S.init(MP, 5632, G, bx);
            prestage<true, true>(L, S, SS, (layer & 1) ? 8 : 4, args.in[24] + (size_t)layer * 3 * 5632, args.in[25] + (size_t)layer * 5632);
            pg8::EpiUp E{ACT, HALO, (LAS const float*)(L + XL_RS), (LAS const float*)(L + XL_CV)};
            pg8::gemm_phase<pg8::EpiUp, pg8::StaticOrder, true, true, true>(L, g, S, E);
        } else if (kind == K_DN && EN(K_DN)) {
            pg8::Gemm g{ACT, (const bf16*)(ws + WS_WDN) + (size_t)layer * 1024 * 2816, MP, 1024, 2816}; pg8::StaticOrder S; S.init(MP, 1024, G, bx);
            { pg8::Unit u0; for (int i = 0; S.next(i, u0); ++i) ffn_fixup(u0.pm, u0.pn == 0, HALO, args.in[24] + (size_t)layer * 3 * 5632, args.in[25] + (size_t)layer * 5632, ACT, out + O_CP + (size_t)layer * NB * 2 * 5632); }
            if (SAMPLE) for (int u = G - 1 - bx; u < 256; u += G) sg::unit<sg::M_RES, 2816, 2>(u, ACT + (size_t)MP * 2816, (const bf16*)(ws + WS_WDN) + (size_t)layer * 1024 * 2816, sp, L);
            __builtin_amdgcn_s_waitcnt(0x0F70); VM_WAIT(); __syncthreads();
            __builtin_amdgcn_s_waitcnt(0x0F70);
            pg8::EpiRes E{layer == DEPTH - 1 ? x : nullptr, XB, SS};
            pg8::gemm_phase<pg8::EpiRes, pg8::StaticOrder, true, true, false>(L, g, S, E);
        }
        if (ph + 1 < args.ph_hi) xcd_barrier(bar);
    }
}
extern "C" void kernel_launch(void* const* d_in, const int* in_sizes, int n_in, void* d_out, int out_size, void* d_ws, size_t ws_size, hipStream_t stream) {
    static int grid = 0;
    if (grid == 0) {
        if (n_in != 27 || ws_size < WS_END || (size_t)out_size != O_END) { fprintf(stderr, "kernel_launch: unexpected sizes: n_in %d ws %zu out %d\n", n_in, ws_size, out_size); grid = -1; return; }
        int dev = 0, cus = 0, per_cu = 0;
        if (hipGetDevice(&dev) != hipSuccess || hipDeviceGetAttribute(&cus, hipDeviceAttributeMultiprocessorCount, dev) != hipSuccess) { grid = -1; return; }
        if (hipFuncSetAttribute((const void*)mega_fwd, hipFuncAttributeMaxDynamicSharedMemorySize, LDS_BYTES) != hipSuccess) { fprintf(stderr, "kernel_launch: hipFuncSetAttribute failed\n"); grid = -1; return; }
        if (hipOccupancyMaxActiveBlocksPerMultiprocessor(&per_cu, (const void*)mega_fwd, NWAVES * 64, LDS_BYTES) != hipSuccess || per_cu < 1) { fprintf(stderr, "kernel_launch: occupancy query says %d blocks per CU\n", per_cu); grid = -1; (void)hipGetLastError(); return; }
        (void)hipGetLastError();
        if (cus < 256) { fprintf(stderr, "kernel_launch: %d CUs; this kernel's phase programs are laid out for 256 co-resident workgroups\n", cus); grid = -1; return; }
        grid = 256;
    }
    if (grid < 0) return;
    (void)hipMemsetAsync((unsigned char*)d_ws + WS_CTL, 0, CTL_ZERO_BYTES, stream);
    Args a{}; for (int i = 0; i < 27; ++i) a.in[i] = (const float*)d_in[i];
    a.out = (float*)d_out; a.ws = (unsigned char*)d_ws; a.ph_lo = 0; a.ph_hi = N_PHASES; a.li = 0;
    hipLaunchKernelGGL(mega_fwd, dim3(grid), dim3(NWAVES * 64), LDS_BYTES, stream, a);
}
```
